# Optimizing an MI355X kernel written in HIP

```python
import math
import jax, jax.numpy as jnp
from jax import lax
import numpy as np

D_MODEL = 1024
BATCH = 2
SEQ = 8192
DEPTH = 2

N_MIXERS = 2
EXPAND = 2
E_WIDTH = EXPAND * D_MODEL
HEAD_DIM = 128
N_SLOTS = E_WIDTH // HEAD_DIM
DILATED_GROUPS = ((128, 1), (512, 4), (2048, 16))
N_GROUPS = 3
ROT_DIM = HEAD_DIM // 4
ROPE_THETA = 500000.0
BLOCK = 128
POOL_WINDOWS = (2, 4, 8, 16)
N_POOL = 4
POOL_CH = E_WIDTH // N_POOL
RMS_EPS = 1e-6
NEG_INF = -1e30
N_ATTN_LAYERS = (DEPTH + 1) // 2
N_POOL_LAYERS = DEPTH // 2

kernel_name = "hybrid_dilated_attn_multiscale_pool"


def rmsnorm(x, g):
    x32 = x.astype(jnp.float32)
    y = x32 * lax.rsqrt(jnp.mean(x32 * x32, axis=-1, keepdims=True) + RMS_EPS)
    return (y * g.astype(jnp.float32)).astype(x.dtype)


def rope_partial(t, cos, sin):
    t32 = t.astype(jnp.float32)
    half = ROT_DIM // 2
    t1 = t32[..., :half]
    t2 = t32[..., half:ROT_DIM]
    out = jnp.concatenate([t1 * cos - t2 * sin, t2 * cos + t1 * sin, t32[..., ROT_DIM:]], axis=-1)
    return out.astype(t.dtype)


def dilated_window_attention(q, k, v, dilation, w_sub):
    B, S, H, Dh = q.shape
    L = S // dilation
    nb = -(-L // BLOCK)
    Lp = nb * BLOCK
    N = B * dilation

    def to_sub(t):
        t = t.reshape(B, L, dilation, H, Dh).transpose(0, 2, 1, 3, 4).reshape(N, L, H, Dh)
        return jnp.pad(t, ((0, 0), (0, Lp - L), (0, 0), (0, 0)))

    def band_keys(t):
        tp = jnp.pad(t, ((0, 0), (BLOCK, 0), (0, 0), (0, 0))).reshape(N, nb + 1, BLOCK, H, Dh)
        return jnp.concatenate([tp[:, :-1], tp[:, 1:]], axis=2)

    qs = to_sub(q).reshape(N, nb, BLOCK, H, Dh)
    kw = band_keys(to_sub(k))
    vw = band_keys(to_sub(v))

    qi = jnp.arange(BLOCK)[:, None]
    kj = jnp.arange(2 * BLOCK)[None, :]
    dist = qi + BLOCK - kj
    band = (dist >= 0) & (dist <= w_sub)
    not_first = (jnp.arange(nb) > 0)[:, None, None]
    valid = band[None] & (not_first | (kj >= BLOCK)[None])

    scale = 1.0 / math.sqrt(Dh)
    s = jnp.einsum('nbqhd,nbkhd->nbhqk', qs, kw).astype(jnp.float32) * scale
    s = jnp.where(valid[None, :, None], s, NEG_INF)
    m = jnp.max(s, axis=-1, keepdims=True)
    p = jnp.exp(s - m)
    den = jnp.sum(p, axis=-1)
    o = jnp.einsum('nbhqk,nbkhd->nbqhd', p, vw.astype(jnp.float32))
    o = o / jnp.transpose(den, (0, 1, 3, 2))[..., None]
    lse = jnp.transpose(m[..., 0] + jnp.log(den), (0, 1, 3, 2))

    o = o.reshape(N, Lp, H, Dh)[:, :L].reshape(B, dilation, L, H, Dh)
    o = o.transpose(0, 2, 1, 3, 4).reshape(B, S, H, Dh)
    lse = lse.reshape(N, Lp, H)[:, :L].reshape(B, dilation, L, H)
    lse = lse.transpose(0, 2, 1, 3).reshape(B, S, H)
    return o, lse


def attention_mixer(xn, cos, sin, w_in, w_out):
    B, S, D = xn.shape
    qkv_cols = N_GROUPS * 3 * E_WIDTH
    w_qkv = w_in[:, :qkv_cols].reshape(D, N_GROUPS, 3, N_SLOTS, HEAD_DIM)
    z = xn @ w_in[:, qkv_cols:]
    outs, lses = [], []
    for g, (window, dil) in enumerate(DILATED_GROUPS):
        qkv = jnp.einsum('bsd,dchk->cbshk', xn, w_qkv[:, g])
        q = rope_partial(qkv[0], cos, sin)
        k = rope_partial(qkv[1], cos, sin)
        o, lse = dilated_window_attention(q, k, qkv[2], dil, window // dil)
        outs.append(o)
        lses.append(lse)
    wts = jax.nn.softmax(jnp.stack(lses, axis=0), axis=0)
    y = jnp.sum(wts[..., None] * jnp.stack(outs, axis=0), axis=0)
    y = y.reshape(B, S, E_WIDTH).astype(xn.dtype) * jax.nn.silu(z)
    return y @ w_out


def pooling_mixer(xn, w_in, w_grp, b_grp, scale, w_out):
    B, S, D = xn.shape
    uz = xn @ w_in
    u, z = uz[..., :E_WIDTH], uz[..., E_WIDTH:]
    ug = u.reshape(B, S, N_POOL, POOL_CH).astype(jnp.float32)
    c = jnp.cumsum(ug, axis=1)
    t = jnp.arange(S)
    parts = []
    for g, w in enumerate(POOL_WINDOWS):
        cg = c[:, :, g]
        lag = jnp.pad(cg[:, :S - w], ((0, 0), (w, 0), (0, 0)))
        cnt = jnp.minimum(t + 1, w).astype(jnp.float32)[None, :, None]
        parts.append((cg - lag) / cnt)
    pooled = (jnp.stack(parts, axis=2) - ug).astype(xn.dtype)
    h = jnp.einsum('bsgc,gcd->bsgd', pooled, w_grp) + b_grp
    h = h.reshape(B, S, E_WIDTH) * scale
    y = h * jax.nn.silu(z)
    return y @ w_out


def setup_inputs(seed: int = 0) -> dict:
    key = jax.random.key(seed)
    ks = jax.random.split(key, 12)
    D, E = D_MODEL, E_WIDTH
    f32 = jnp.float32
    x = jax.random.normal(ks[0], (BATCH, SEQ, D), f32)
    offset = jax.random.randint(ks[1], (BATCH, 1), 0, 4096, dtype=jnp.int32)
    positions = (offset + jnp.arange(SEQ, dtype=jnp.int32)[None, :]).astype(jnp.int32)
    norm_pre = 1.0 + 0.1 * jax.random.normal(ks[2], (DEPTH, D), f32)
    norm_post = 1.0 + 0.1 * jax.random.normal(ks[3], (DEPTH, D), f32)
    attn_w_in = jax.random.normal(ks[4], (N_ATTN_LAYERS, D, N_GROUPS * 3 * E + E), f32) * D ** -0.5
    attn_w_out = jax.random.normal(ks[5], (N_ATTN_LAYERS, E, D), f32) * E ** -0.5
    pool_w_in = jax.random.normal(ks[6], (N_POOL_LAYERS, D, 2 * E), f32) * D ** -0.5
    pool_w_grp = jax.random.normal(ks[7], (N_POOL_LAYERS, N_POOL, POOL_CH, POOL_CH), f32) * POOL_CH ** -0.5
    pool_b_grp = 0.01 * jax.random.normal(ks[8], (N_POOL_LAYERS, N_POOL, POOL_CH), f32)
    pool_scale = 1.0 + 0.1 * jax.random.normal(ks[9], (N_POOL_LAYERS, E), f32)
    pool_w_out = jax.random.normal(ks[10], (N_POOL_LAYERS, E, D), f32) * E ** -0.5
    return {"x": x, "positions": positions, "norm_pre": norm_pre, "norm_post": norm_post,
            "attn_w_in": attn_w_in, "attn_w_out": attn_w_out,
            "pool_w_in": pool_w_in, "pool_w_grp": pool_w_grp, "pool_b_grp": pool_b_grp,
            "pool_scale": pool_scale, "pool_w_out": pool_w_out}


def reference(x, positions, norm_pre, norm_post, attn_w_in, attn_w_out,
              pool_w_in, pool_w_grp, pool_b_grp, pool_scale, pool_w_out):
    inv_freq = ROPE_THETA ** (-jnp.arange(0, ROT_DIM, 2, dtype=jnp.float32) / ROT_DIM)
    ang = positions.astype(jnp.float32)[..., None] * inv_freq
    cos = jnp.cos(ang)[:, :, None, :]
    sin = jnp.sin(ang)[:, :, None, :]
    h = x
    for i in range(DEPTH):
        xn = rmsnorm(h, norm_pre[i])
        j = i // N_MIXERS
        if i % N_MIXERS == 0:
            y = attention_mixer(xn, cos, sin, attn_w_in[j], attn_w_out[j])
        else:
            y = pooling_mixer(xn, pool_w_in[j], pool_w_grp[j], pool_b_grp[j],
                              pool_scale[j], pool_w_out[j])
        h = h + rmsnorm(y, norm_post[i])
    return h
```

```cpp
#include <hip/hip_runtime.h>
#include <cstdio>
#include <cstdint>
#include <cmath>
namespace pg8 {
#define PG8_LAS __attribute__((address_space(3)))
typedef unsigned short bf16_t;
typedef short bf16x8 __attribute__((ext_vector_type(8)));
typedef float f32x4 __attribute__((ext_vector_type(4)));
typedef unsigned u32x4 __attribute__((ext_vector_type(4)));
constexpr int BM = 256, BK = 64, HALF = 128, HTB = HALF * BK * 2  , STAGE_BYTES = 8 * HTB, NXCD = 8, WGM = 8;

__host__ __device__ __forceinline__ int lds_byte(int r, int c) { const int st = (r >> 4) * 2 + (c >> 5), rr = r & 15, cc = c & 31, ob = rr * 64 + cc * 2; return st * 1024 + (ob ^ (((ob >> 9) & 1) << 5)); }
__host__ __device__ __forceinline__ void stage_rc(int b, int& R, int& C) { const int st = b / 1024, sb = b % 1024, swz = sb ^ (((sb >> 9) & 1) << 5); R = (st >> 1) * 16 + swz / 64; C = (st & 1) * 32 + (swz % 64) / 2; }
__host__ __device__ __forceinline__ int perm32(int rho) { const int n = rho >> 4, i = rho & 15; return 8 * (i >> 2) + 4 * n + (i & 3); }

struct Unit { int pm, pn; };
struct Gemm { const bf16_t* A; const bf16_t* Bt; int M, N, K; };

struct StaticOrder {
    int nM, nN, nwg, G, c;
    __host__ __device__ void init(int M, int N, int G_, int c_) { nM = M / BM; nN = N / BM; nwg = nM * nN; G = G_; c = c_; }
    __host__ __device__ bool next(int i, Unit& u) const {
        const long L = (long)i * G + c; if (L >= nwg) return false;
        int wgid = (int)L; { const int q = nwg / NXCD, r = nwg % NXCD, xcd = wgid % NXCD, off = wgid / NXCD; wgid = (xcd < r ? xcd * (q + 1) : r * (q + 1) + (xcd - r) * q) + off; }
        const int nig = WGM * nN, gid = wgid / nig, fm = gid * WGM, gsz = (nM - fm) < WGM ? (nM - fm) : WGM;
        u.pm = fm + ((wgid % nig) % gsz); u.pn = (wgid % nig) / gsz; return true;
    }
    __device__ __forceinline__ void a_ready(const Unit&) const {}
    __device__ __forceinline__ void done(const Unit&) const {}
};

__device__ __forceinline__ unsigned cvt_pk_bf16(float lo, float hi) { unsigned r; asm volatile("v_cvt_pk_bf16_f32 %0, %1, %2" : "=v"(r) : "v"(lo), "v"(hi)); return r; }
typedef float f32x2 __attribute__((ext_vector_type(2)));
typedef unsigned u32x2 __attribute__((ext_vector_type(2)));
__device__ __forceinline__ float silu_f(float v) { return v * __builtin_amdgcn_rcpf(1.0f + __builtin_amdgcn_exp2f(-1.4426950408889634f * v)); }

struct EpiF32 {
    static constexpr bool PERM = false, AFTER_DRAIN = false;
    float* C; int ldc;
    __device__ __forceinline__ void operator()(const f32x4 (&acc)[2][2][4][2], const Unit& u, int wr, int wc, int fr, int fq) const {
        const int row0 = u.pm * BM + wr * 64 + fr, col0 = u.pn * BM + wc * 32 + 4 * fq;
#pragma unroll
        for (int ai = 0; ai < 2; ++ai)
#pragma unroll
            for (int m = 0; m < 4; ++m) { float* rowp = C + (size_t)(row0 + ai * HALF + m * 16) * ldc + col0;
#pragma unroll
                for (int bj = 0; bj < 2; ++bj)
#pragma unroll
                    for (int n = 0; n < 2; ++n) *(f32x4*)(rowp + bj * HALF + n * 16) = acc[ai][bj][m][n]; }
    }
};

struct EpiVZ {
    static constexpr bool PERM = true, AFTER_DRAIN = false;
    bf16_t* V; bf16_t* SZ;
    __device__ __forceinline__ void operator()(const f32x4 (&acc)[2][2][4][2], const Unit& u, int wr, int wc, int fr, int fq) const {
        const int row0 = u.pm * BM + wr * 64 + fr; const bool isz = u.pn >= 8;
        bf16_t* base = isz ? SZ : V; const int col0 = (isz ? u.pn - 8 : u.pn) * BM + wc * 32 + 8 * fq;
#pragma unroll
        for (int ai = 0; ai < 2; ++ai)
#pragma unroll
            for (int m = 0; m < 4; ++m) { bf16_t* rowp = base + (size_t)(row0 + ai * HALF + m * 16) * 2048 + col0;
#pragma unroll
                for (int bj = 0; bj < 2; ++bj) { f32x4 v0 = acc[ai][bj][m][0], v1 = acc[ai][bj][m][1];
                    if (isz) { v0 = (f32x4){silu_f(v0[0]), silu_f(v0[1]), silu_f(v0[2]), silu_f(v0[3])}; v1 = (f32x4){silu_f(v1[0]), silu_f(v1[1]), silu_f(v1[2]), silu_f(v1[3])}; }
                    u32x4 w; w.x = cvt_pk_bf16(v0[0], v0[1]); w.y = cvt_pk_bf16(v0[2], v0[3]); w.z = cvt_pk_bf16(v1[0], v1[1]); w.w = cvt_pk_bf16(v1[2], v1[3]);
                    *(u32x4*)(rowp + bj * HALF) = w; } }
    }
};

template <int LOGD> struct EpiQKV {
    static constexpr bool PERM = true, AFTER_DRAIN = false;
    bf16_t* QKV; bf16_t* SZ; const float* rope;
    __device__ __forceinline__ void operator()(const f32x4 (&acc)[2][2][4][2], const Unit& u, int wr, int wc, int fr, int fq) const {
        constexpr int LOGL = 13 - LOGD, DM1 = (1 << LOGD) - 1;
        const int row0 = u.pm * BM + wr * 64 + fr;
        if (u.pn >= 24) {
            const int col0 = (u.pn - 24) * BM + wc * 32 + 8 * fq;
#pragma unroll
            for (int ai = 0; ai < 2; ++ai)
#pragma unroll
                for (int m = 0; m < 4; ++m) { bf16_t* rowp = SZ + (size_t)(row0 + ai * HALF + m * 16) * 2048 + col0;
#pragma unroll
                    for (int bj = 0; bj < 2; ++bj) { const f32x4 v0 = acc[ai][bj][m][0], v1 = acc[ai][bj][m][1];
                        u32x4 w; w.x = cvt_pk_bf16(silu_f(v0[0]), silu_f(v0[1])); w.y = cvt_pk_bf16(silu_f(v0[2]), silu_f(v0[3]));
                        w.z = cvt_pk_bf16(silu_f(v1[0]), silu_f(v1[1])); w.w = cvt_pk_bf16(silu_f(v1[2]), silu_f(v1[3]));
                        *(u32x4*)(rowp + bj * HALF) = w; } }
            return;
        }
        const int c = u.pn >> 3, hp = u.pn & 7;
        bf16_t* base = QKV + (size_t)c * ((size_t)32 * 8192 * 128);
        const bool rot = (c < 2) && (wc == 0);
        const float sgn = (fq < 2) ? -1.f : 1.f;
#pragma unroll
        for (int ai = 0; ai < 2; ++ai)
#pragma unroll
            for (int m = 0; m < 4; ++m) {
                const int row = row0 + ai * HALF + m * 16, b = row >> 13, t = row & 8191;
                const int srow = ((t & DM1) << LOGL) + (t >> LOGD);
                f32x4 cs0, cs1, sn0, sn1;
                if (rot) { const float* rp = rope + (size_t)row * 32 + 8 * (fq & 1);
                    cs0 = *(const f32x4*)rp; cs1 = *(const f32x4*)(rp + 4); sn0 = *(const f32x4*)(rp + 16); sn1 = *(const f32x4*)(rp + 20); }
#pragma unroll
                for (int bj = 0; bj < 2; ++bj) {
                    f32x4 v0 = acc[ai][bj][m][0], v1 = acc[ai][bj][m][1];
                    if (rot) {
                        f32x4 p0, p1;
#pragma unroll
                        for (int j = 0; j < 4; ++j) { p0[j] = __shfl_xor(v0[j], 32); p1[j] = __shfl_xor(v1[j], 32); }
                        v0 = v0 * cs0 + (p0 * sn0) * sgn; v1 = v1 * cs1 + (p1 * sn1) * sgn;
                    }
                    const int h = hp * 2 + bj;
                    bf16_t* dst = base + ((size_t)((b * 16 + h) << 13) + srow) * 128 + wc * 32 + 8 * fq;
                    u32x4 w; w.x = cvt_pk_bf16(v0[0], v0[1]); w.y = cvt_pk_bf16(v0[2], v0[3]); w.z = cvt_pk_bf16(v1[0], v1[1]); w.w = cvt_pk_bf16(v1[2], v1[3]);
                    *(u32x4*)dst = w;
                }
            }
    }
};
template <class Epi, class Sched, bool ALIGN_EPI = false, bool SP2 = false>
__device__ __forceinline__ void gemm_phase(PG8_LAS unsigned char* lds, const Gemm g, const Sched& S, const Epi& E) {
    const int tid = threadIdx.x, wid = __builtin_amdgcn_readfirstlane(tid >> 6), lane = tid & 63, wr = wid >> 2, wc = wid & 3, fr = lane & 15, fq = lane >> 4;
    const int K = g.K, nt = K / BK;
    unsigned voffA[2], voffB[2];
#pragma unroll
    for (int i = 0; i < 2; ++i) { int R, C; stage_rc(tid * 16 + i * 8192, R, C); const int Rb = Epi::PERM ? ((R & ~31) + perm32(R & 31)) : R;
        voffA[i] = (unsigned)(R * K + C) * 2u; voffB[i] = (unsigned)(Rb * K + C) * 2u; }
    const size_t kstep = (size_t)(BK * 2);
    const size_t hstep = (size_t)HALF * K * 2;
    const size_t tstep = 2 * hstep;
    const unsigned ldsw = (unsigned)wid * 1024u;
    const int aoff = lds_byte(wr * 64 + fr, fq * 8), boff = lds_byte(wc * 32 + fr, fq * 8);
#define PG8_SA(b, h) (((b) * 2 + (h)) * HTB)
#define PG8_SB(b, h) ((4 + (b) * 2 + (h)) * HTB)
#define PG8_STAGE(bufoff, gbase, voff) do { _Pragma("unroll") for (int _i = 0; _i < 2; ++_i) \
        __builtin_amdgcn_global_load_lds((const unsigned*)((const char*)(gbase) + (voff)[_i]), (PG8_LAS unsigned*)(lds + (bufoff) + ldsw + _i * 8192), 16, 0, 0); } while (0)
#define PG8_LDA(dst, b, h) do { _Pragma("unroll") for (int m = 0; m < 4; ++m) _Pragma("unroll") for (int k = 0; k < 2; ++k) dst[m][k] = *(const PG8_LAS bf16x8*)(lds + PG8_SA(b, h) + aoff + m * 2048 + k * 1024); } while (0)
#define PG8_LDB(dst, b, h) do { _Pragma("unroll") for (int n = 0; n < 2; ++n) _Pragma("unroll") for (int k = 0; k < 2; ++k) dst[n][k] = *(const PG8_LAS bf16x8*)(lds + PG8_SB(b, h) + boff + n * 2048 + k * 1024); } while (0)
#define PG8_MMA(ai, bj, At, Bt) do { __builtin_amdgcn_s_setprio(1); _Pragma("unroll") for (int m = 0; m < 4; ++m) _Pragma("unroll") for (int n = 0; n < 2; ++n) _Pragma("unroll") for (int k = 0; k < 2; ++k) \
        acc[ai][bj][m][n] = __builtin_amdgcn_mfma_f32_16x16x32_bf16(Bt[n][k], At[m][k], acc[ai][bj][m][n], 0, 0, 0); __builtin_amdgcn_s_setprio(0); } while (0)
#define PG8_WAIT_V(n) asm volatile("s_waitcnt vmcnt(" #n ")" ::: "memory")
#define PG8_WAIT_L(n) asm volatile("s_waitcnt lgkmcnt(" #n ")" ::: "memory")
#define PG8_BAR __builtin_amdgcn_s_barrier()
#define PG8_SCHED __builtin_amdgcn_sched_barrier(0)
    Unit cur, nxt; int ui = 0;
    if (!S.next(0, cur)) return;
    f32x4 acc[2][2][4][2];
#pragma unroll
    for (int a = 0; a < 2; ++a)
#pragma unroll
        for (int b = 0; b < 2; ++b)
#pragma unroll
            for (int m = 0; m < 4; ++m)
#pragma unroll
                for (int n = 0; n < 2; ++n) acc[a][b][m][n] = (f32x4){0.f, 0.f, 0.f, 0.f};
    bf16x8 At[4][2], B0[2][2], B1[2][2];
    const char* cA = (const char*)g.A + (size_t)cur.pm * tstep; const char* cB = (const char*)g.Bt + (size_t)cur.pn * tstep;
    S.a_ready(cur);
    if constexpr (SP2) {
        PG8_STAGE(PG8_SB(0, 0), cB, voffB); PG8_STAGE(PG8_SB(0, 1), cB + hstep, voffB); PG8_STAGE(PG8_SA(0, 0), cA, voffA); PG8_STAGE(PG8_SA(0, 1), cA + hstep, voffA);
        if (wr == 1) PG8_BAR;
        PG8_WAIT_V(2); PG8_BAR;
        PG8_STAGE(PG8_SB(1, 0), cB + kstep, voffB); PG8_STAGE(PG8_SA(1, 0), cA + kstep, voffA); PG8_STAGE(PG8_SB(1, 1), cB + hstep + kstep, voffB);
        PG8_WAIT_V(6); PG8_BAR;
    } else {
        PG8_STAGE(PG8_SB(0, 0), cB, voffB); PG8_STAGE(PG8_SA(0, 0), cA, voffA); PG8_STAGE(PG8_SB(0, 1), cB + hstep, voffB); PG8_STAGE(PG8_SA(0, 1), cA + hstep, voffA);
        if (wr == 1) PG8_BAR;
        PG8_WAIT_V(4); PG8_BAR;
        PG8_STAGE(PG8_SB(1, 0), cB + kstep, voffB); PG8_STAGE(PG8_SA(1, 0), cA + kstep, voffA); PG8_STAGE(PG8_SB(1, 1), cB + hstep + kstep, voffB);
        PG8_WAIT_V(6); PG8_BAR;
    }
    for (;;) {
        const bool has_next = S.next(ui + 1, nxt);
        const char* nA = has_next ? (const char*)g.A + (size_t)nxt.pm * tstep : cA; const char* nB = has_next ? (const char*)g.Bt + (size_t)nxt.pn * tstep : cB;
        for (int t = 0; t < nt; t += 2) {
            const bool last = (t == nt - 2);
            const char* a1 = cA + (size_t)(t + 1) * kstep;
            const char* a2 = last ? nA : cA + (size_t)(t + 2) * kstep; const char* b2 = last ? nB : cB + (size_t)(t + 2) * kstep;
            const char* a3 = a2 + kstep; const char* b3 = b2 + kstep;
            if (last && has_next) S.a_ready(nxt);
            if constexpr (SP2) {
            PG8_LDB(B0, 0, 0); PG8_LDB(B1, 0, 1); PG8_SCHED; PG8_LDA(At, 0, 0); PG8_STAGE(PG8_SA(1, 1), a1 + hstep, voffA);
            PG8_WAIT_V(8); PG8_WAIT_L(0); PG8_BAR; PG8_MMA(0, 0, At, B0); PG8_MMA(0, 1, At, B1); PG8_BAR; PG8_SCHED;
            PG8_LDA(At, 0, 1); PG8_STAGE(PG8_SB(0, 0), b2, voffB); PG8_STAGE(PG8_SB(0, 1), b2 + hstep, voffB); PG8_STAGE(PG8_SA(0, 0), a2, voffA);
            PG8_WAIT_V(8); PG8_WAIT_L(0); PG8_BAR; PG8_MMA(1, 0, At, B0); PG8_MMA(1, 1, At, B1); PG8_BAR; PG8_SCHED;
            PG8_LDB(B0, 1, 0); PG8_LDB(B1, 1, 1); PG8_SCHED; PG8_LDA(At, 1, 0); PG8_STAGE(PG8_SA(0, 1), a2 + hstep, voffA);
            PG8_WAIT_V(8); PG8_WAIT_L(0); PG8_BAR; PG8_MMA(0, 0, At, B0); PG8_MMA(0, 1, At, B1); PG8_BAR; PG8_SCHED;
            PG8_LDA(At, 1, 1); PG8_STAGE(PG8_SB(1, 0), b3, voffB); PG8_STAGE(PG8_SB(1, 1), b3 + hstep, voffB); PG8_STAGE(PG8_SA(1, 0), a3, voffA);
            PG8_WAIT_V(8); PG8_WAIT_L(0); PG8_BAR; PG8_MMA(1, 0, At, B0); PG8_MMA(1, 1, At, B1); PG8_BAR; PG8_SCHED;
            } else {
            PG8_LDB(B0, 0, 0); PG8_SCHED; PG8_LDA(At, 0, 0); PG8_STAGE(PG8_SA(1, 1), a1 + hstep, voffA);
            PG8_WAIT_L(8); PG8_BAR; PG8_WAIT_L(0); PG8_MMA(0, 0, At, B0); PG8_BAR; PG8_SCHED;
            PG8_LDB(B1, 0, 1); PG8_STAGE(PG8_SB(0, 0), b2, voffB);
            PG8_BAR; PG8_WAIT_L(0); PG8_MMA(0, 1, At, B1); PG8_BAR;
            PG8_LDA(At, 0, 1); PG8_STAGE(PG8_SA(0, 0), a2, voffA);
            PG8_BAR; PG8_WAIT_L(0); PG8_MMA(1, 0, At, B0); PG8_BAR; PG8_SCHED;
            PG8_STAGE(PG8_SB(0, 1), b2 + hstep, voffB);
            PG8_WAIT_V(6); PG8_BAR; PG8_MMA(1, 1, At, B1); PG8_BAR;
            PG8_LDB(B0, 1, 0); PG8_SCHED; PG8_LDA(At, 1, 0); PG8_STAGE(PG8_SA(0, 1), a2 + hstep, voffA);
            PG8_WAIT_L(8); PG8_BAR; PG8_WAIT_L(0); PG8_MMA(0, 0, At, B0); PG8_BAR; PG8_SCHED;
            PG8_LDB(B1, 1, 1); PG8_STAGE(PG8_SB(1, 0), b3, voffB);
            PG8_BAR; PG8_WAIT_L(0); PG8_MMA(0, 1, At, B1); PG8_BAR;
            PG8_LDA(At, 1, 1); PG8_STAGE(PG8_SA(1, 0), a3, voffA);
            PG8_BAR; PG8_WAIT_L(0); PG8_MMA(1, 0, At, B0); PG8_BAR; PG8_SCHED;
            PG8_STAGE(PG8_SB(1, 1), b3 + hstep, voffB);
            PG8_WAIT_V(6); PG8_BAR; PG8_MMA(1, 1, At, B1); PG8_BAR;
            }
        }
        if constexpr (ALIGN_EPI) { if (wr == 0) PG8_BAR; }
        if constexpr (!Epi::AFTER_DRAIN) { E(acc, cur, wr, wc, fr, fq); S.done(cur); }
        if (!has_next) break;
#pragma unroll
        for (int a = 0; a < 2; ++a)
#pragma unroll
            for (int b = 0; b < 2; ++b)
#pragma unroll
                for (int m = 0; m < 4; ++m)
#pragma unroll
                    for (int n = 0; n < 2; ++n) acc[a][b][m][n] = (f32x4){0.f, 0.f, 0.f, 0.f};
        cur = nxt; cA = nA; cB = nB; ++ui;
        if constexpr (ALIGN_EPI) { if (wr == 1) PG8_BAR; }
    }
    PG8_WAIT_V(0);
    if constexpr (!ALIGN_EPI) { if (wr == 0) PG8_BAR; }
    PG8_BAR;
    if constexpr (Epi::AFTER_DRAIN) { E.fused(acc, cur, wr, wc, fr, fq, lds, wid, lane); S.done(cur); }
#undef PG8_SA
#undef PG8_SB
#undef PG8_STAGE
#undef PG8_LDA
#undef PG8_LDB
#undef PG8_MMA
#undef PG8_WAIT_V
#undef PG8_WAIT_L
#undef PG8_BAR
#undef PG8_SCHED
}
}
#define GAS __attribute__((address_space(1)))
#define LAS __attribute__((address_space(3)))
typedef unsigned short bf16;
typedef unsigned v4u __attribute__((ext_vector_type(4)));
typedef float f32x4 __attribute__((ext_vector_type(4)));
typedef short bf16x8 __attribute__((ext_vector_type(8)));
typedef GAS unsigned gu32;
typedef GAS unsigned long long gu64;
#define RLX_AGENT __ATOMIC_RELAXED, __HIP_MEMORY_SCOPE_AGENT
#define LDS_WAIT() asm volatile("s_waitcnt lgkmcnt(0)" ::: "memory")
#define VM_WAIT() asm volatile("s_waitcnt vmcnt(0)" ::: "memory")
__device__ __forceinline__ unsigned long long rt() { return __builtin_amdgcn_s_memrealtime(); }
__device__ __forceinline__ unsigned f2bf(float f) { unsigned u = __builtin_bit_cast(unsigned, f); return (u + 0x7fffu + ((u >> 16) & 1u)) >> 16; }
__device__ __forceinline__ unsigned pk2(float lo, float hi) { return f2bf(lo) | (f2bf(hi) << 16); }

#define XB_TMO      128
#define XB_XCNT(j)  (256  + 64 * (j))
#define XB_XSUB(j)  (1280 + 64 * (j))
#define XB_XGEN(j)  (2304 + 64 * (j))
#define XB_TOP      3328
#define XB_TOPGEN   3392
#define XCD_BAR_WORDS 3456
#define XB_SPIN_CAP (1u << 18)

__device__ __forceinline__ unsigned xb_ld(unsigned* p)              { return __hip_atomic_load(p, __ATOMIC_RELAXED, __HIP_MEMORY_SCOPE_AGENT); }
__device__ __forceinline__ unsigned xb_add(unsigned* p, unsigned v) { return __hip_atomic_fetch_add(p, v, __ATOMIC_RELAXED, __HIP_MEMORY_SCOPE_AGENT); }
__device__ __forceinline__ unsigned xb_xcc_id() { return (unsigned)__builtin_amdgcn_s_getreg((3 << 11) | 20) & 0xFu; }
#define XB_SPIN(cond, bar) do { unsigned _sp = 0; while (cond) { __builtin_amdgcn_s_sleep(1); \
    if ((++_sp & 255u) == 0u) { if (xb_ld(&(bar)[XB_TMO])) break; if (_sp > XB_SPIN_CAP) { atomicAdd(&(bar)[XB_TMO], 1u); break; } } } } while (0)

struct XcdBarrier {
    unsigned* bar; unsigned x;
    volatile LAS unsigned* st;
};

__device__ __forceinline__ XcdBarrier xcd_barrier_post(unsigned* bar, volatile LAS unsigned* st) {
    XcdBarrier b; b.bar = bar; b.x = xb_xcc_id(); b.st = st;
    if (threadIdx.x == 0) (void)xb_add(&bar[XB_XCNT(b.x)], 1u);
    return b;
}
__device__ __forceinline__ void xcd_barrier_complete(unsigned* bar, unsigned x, unsigned& nloc, unsigned& nx) {
    const unsigned G = gridDim.x * gridDim.y * gridDim.z;
    unsigned sum, cnt, mine, sp = 0u;
    for (;;) {
        sum = 0u; cnt = 0u; mine = 0u;
#pragma unroll
        for (unsigned j = 0; j < 16; ++j) { const unsigned c = xb_ld(&bar[XB_XCNT(j)]); sum += c; cnt += (c > 0u) ? 1u : 0u; mine = (j == x) ? c : mine; }
        if (sum == G) break;
        __builtin_amdgcn_s_sleep(1);
        if ((++sp & 255u) == 0u) { if (xb_ld(&bar[XB_TMO])) break; if (sp > XB_SPIN_CAP) { atomicAdd(&bar[XB_TMO], 1u); break; } }
    }
    nloc = mine > 0u ? mine : 1u; nx = cnt > 0u ? cnt : 1u;
}

__device__ __forceinline__ void xcd_barrier(const XcdBarrier& b) {
    asm volatile("s_waitcnt vmcnt(0)" ::: "memory");
    __syncthreads();
    if (threadIdx.x == 0) {
        unsigned* bar = b.bar;
        __builtin_amdgcn_s_waitcnt(0);
        unsigned nloc = b.st[0], nx = b.st[1];
        if (nloc == 0u) { xcd_barrier_complete(bar, b.x, nloc, nx); b.st[0] = nloc; b.st[1] = nx; }
        const unsigned old = xb_add(&bar[XB_XSUB(b.x)], 1u);
        const unsigned gen = old / nloc;
        if (old + 1u == (gen + 1u) * nloc) {
            __builtin_amdgcn_fence(__ATOMIC_RELEASE, "agent");
            asm volatile("s_waitcnt vmcnt(0)" ::: "memory");
            const unsigned og = xb_add(&bar[XB_TOP], 1u);
            const unsigned tg = og / nx;
            if (og + 1u == (tg + 1u) * nx) xb_add(&bar[XB_TOPGEN], 1u);
            else XB_SPIN(xb_ld(&bar[XB_TOPGEN]) == tg, bar);
            __builtin_amdgcn_fence(__ATOMIC_ACQUIRE, "agent");
            xb_add(&bar[XB_XGEN(b.x)], 1u);
            asm volatile("s_waitcnt vmcnt(0)" ::: "memory");
        } else {
            XB_SPIN(xb_ld(&bar[XB_XGEN(b.x)]) == gen, bar);
            __builtin_amdgcn_fence(__ATOMIC_ACQUIRE, "agent");
            asm volatile("s_waitcnt vmcnt(0)" ::: "memory");
        }
    }
    __syncthreads();
}

constexpr int NWAVES = 8;
constexpr int BATCH = 2, SEQ = 8192, DM = 1024, EW = 2048, NHEAD = 16, HD = 128;
constexpr int M = BATCH * SEQ;
constexpr int NIN = 3 * 3 * EW + EW;
constexpr int NGRP = 3 * EW;
constexpr float RMS_EPS = 1e-6f;
constexpr float SM_SCALE = 0.08838834764831845f;
constexpr float LOG2E = 1.4426950408889634f;

constexpr size_t MiB = 1u << 20;
constexpr size_t WS_CTL = 0, CTL_ZERO_BYTES = 256 * 1024;
constexpr size_t WS_XN0  = 1 * MiB;
constexpr size_t WS_QKV  = 33 * MiB;
constexpr size_t WS_SZ   = 225 * MiB;
constexpr size_t WS_WINT_A = 225 * MiB;
constexpr size_t WS_WINT_B = 289 * MiB;
constexpr size_t WS_ROPE = 305 * MiB;
constexpr size_t WS_LSE  = 307 * MiB;
constexpr size_t WS_WP1T  = 1 * MiB;
constexpr size_t WS_WOUTT = 9 * MiB;
constexpr size_t WS_WPOUTT = 13 * MiB;
constexpr size_t WS_H1  = 17 * MiB;
constexpr size_t WS_XN1 = 81 * MiB;
constexpr size_t WS_V1  = 113 * MiB;
constexpr size_t WS_SZ1 = 177 * MiB;
constexpr size_t WS_Y2  = 241 * MiB;
constexpr size_t WS_END = 320 * MiB;
constexpr int CW_TMO = 0, CW_CODE = 1, CW_BAR = 4096;

constexpr int RING_OFF = 0, RING_BYTES = 131072;
constexpr int LDSCTL_OFF = RING_BYTES, MISC_OFF = LDSCTL_OFF + 320;
constexpr int LDS_BYTES = 147456;

struct Frame {
    LAS unsigned char* lds;
    volatile LAS unsigned* MISC;
    gu32* ctl;
    int tid, lane, wave;
    int vcu, G;
};
struct Args {
    const float* x; const int* pos; const float* norm_pre; const float* norm_post; const float* attn_w_in; const float* attn_w_out;
    const float* pool_w_in; const float* pool_w_grp; const float* pool_b_grp; const float* pool_scale; const float* pool_w_out;
    float* out; unsigned char* ws; float inv_freq[16]; int ph_lo, ph_hi, li, pad;
};

__device__ __forceinline__ float wave_sum(float v) {
#pragma unroll
    for (int o = 1; o < 64; o <<= 1) v += __shfl_xor(v, o);
    return v;
}
__device__ __forceinline__ float wave_max(float v) {
#pragma unroll
    for (int o = 1; o < 64; o <<= 1) v = fmaxf(v, __shfl_xor(v, o));
    return v;
}
__device__ __forceinline__ float bf2f(unsigned short h) { return __uint_as_float(((unsigned)h) << 16); }

__device__ __forceinline__ void transpose_tile(const float* src, int ldw, bf16* dst, int ldt, LAS float* scr, int lane) {
#pragma unroll 8
    for (int i = 0; i < 32; ++i) { const int kk = 2 * i + (lane >> 5); scr[kk * 33 + (lane & 31)] = src[(size_t)kk * ldw + (lane & 31)]; }
    LDS_WAIT(); asm volatile("" ::: "memory");
    const int c = lane & 7;
#pragma unroll
    for (int j = 0; j < 4; ++j) { const int n = (lane >> 3) + 8 * j; const LAS float* s = scr + (8 * c) * 33 + n;
        v4u o; o.x = pk2(s[0 * 33], s[1 * 33]); o.y = pk2(s[2 * 33], s[3 * 33]); o.z = pk2(s[4 * 33], s[5 * 33]); o.w = pk2(s[6 * 33], s[7 * 33]);
        *(GAS v4u*)(dst + (size_t)n * ldt + 8 * c) = o; }
    LDS_WAIT(); asm volatile("" ::: "memory");
}
__device__ __forceinline__ void rms_row_to_bf16(const float* xrow, const float* g, bf16* orow, int lane) {
    const GAS f32x4* xr = (const GAS f32x4*)xrow + lane; const GAS f32x4* gr = (const GAS f32x4*)g + lane;
    f32x4 v[4]; float s = 0.f;
#pragma unroll
    for (int j = 0; j < 4; ++j) { v[j] = xr[64 * j]; s += (v[j].x * v[j].x + v[j].y * v[j].y) + (v[j].z * v[j].z + v[j].w * v[j].w); }
    const float r = 1.f / sqrtf(wave_sum(s) * (1.f / DM) + RMS_EPS);
    GAS unsigned long long* o8 = (GAS unsigned long long*)orow + lane;
#pragma unroll
    for (int j = 0; j < 4; ++j) { const f32x4 gg = gr[64 * j]; o8[64 * j] = (unsigned long long)pk2(v[j].x * r * gg.x, v[j].y * r * gg.y) | ((unsigned long long)pk2(v[j].z * r * gg.z, v[j].w * r * gg.w) << 32); }
}
__device__ __forceinline__ void sincos_acc(float af, float& s, float& c) {
    const double a = (double)af;
    const double k = rint(a * 0.63661977236758134308);
    const double y = fma(-k, 1.57079632679489661923, a) - k * 6.123233995736766e-17;
    const double y2 = y * y;
    double sp = -1.0 / 6227020800.0 * 0 + 1.0 / 6227020800.0;
    sp = fma(sp, y2, -1.0 / 39916800.0); sp = fma(sp, y2, 1.0 / 362880.0); sp = fma(sp, y2, -1.0 / 5040.0); sp = fma(sp, y2, 1.0 / 120.0); sp = fma(sp, y2, -1.0 / 6.0); sp = fma(sp, y2, 1.0);
    const double sy = y * sp;
    double cp = 1.0 / 87178291200.0 * -1.0;
    cp = fma(cp, y2, 1.0 / 479001600.0); cp = fma(cp, y2, -1.0 / 3628800.0); cp = fma(cp, y2, 1.0 / 40320.0); cp = fma(cp, y2, -1.0 / 720.0); cp = fma(cp, y2, 1.0 / 24.0); cp = fma(cp, y2, -0.5); cp = fma(cp, y2, 1.0);
    const int q = ((int)(long long)k) & 3;
    const double ss = (q == 0) ? sy : (q == 1) ? cp : (q == 2) ? -sy : -cp;
    const double cc = (q == 0) ? cp : (q == 1) ? -sy : (q == 2) ? -cp : sy;
    s = (float)ss; c = (float)cc;
}

__device__ __forceinline__ void p0_prologue(Frame& F, const Args& a) {
    LAS float* scr = (LAS float*)(F.lds + RING_OFF + F.wave * 16384);
    const int gw = F.vcu * NWAVES + F.wave, NGW = F.G * NWAVES;
    bf16* WA = (bf16*)(a.ws + WS_WINT_A); bf16* WB = (bf16*)(a.ws + WS_WINT_B); bf16* XN0 = (bf16*)(a.ws + WS_XN0);
    constexpr int NB = NIN / 32, NITEMS = (DM / 64) * NB;
    for (int it = gw; it < NITEMS; it += NGW) {
        const int kb = it / NB, nb = it % NB, k0 = 64 * kb, n0 = 32 * nb;
        bf16* dst = (n0 < 2 * NGRP) ? WA + (size_t)n0 * DM + k0 : WB + (size_t)(n0 - 2 * NGRP) * DM + k0;
        transpose_tile(a.attn_w_in + (size_t)k0 * NIN + n0, NIN, dst, DM, scr, F.lane);
    }
    for (int m = gw; m < M; m += NGW) rms_row_to_bf16(a.x + (size_t)m * DM, a.norm_pre, XN0 + (size_t)m * DM, F.lane);
    float* rope = (float*)(a.ws + WS_ROPE);
    constexpr float IF[16] = {1.f, 0.440366596f, 0.193922743f, 0.0853971019f, 0.0376060307f, 0.016560439f, 0.00729266461f, 0.00321144587f,
                              0.00141421356f, 0.000622772379f, 0.000274248188f, 0.000120769735f, 5.3182961e-05f, 2.34199997e-05f, 1.03133862e-05f, 4.54167048e-06f};
    for (int m = F.vcu * 512 + F.tid; m < M; m += F.G * 512) {
        const float p = (float)a.pos[m];
#pragma unroll
        for (int i = 0; i < 16; ++i) { float s, c; sincos_acc(p * IF[i], s, c); rope[(size_t)m * 32 + i] = c; rope[(size_t)m * 32 + 16 + i] = s; }
    }
}

__device__ __forceinline__ void w1_prep(Frame& F, const Args& a) {
    LAS float* scr = (LAS float*)(F.lds + RING_OFF + F.wave * 16384);
    const int gw = F.vcu * NWAVES + F.wave, NGW = F.G * NWAVES, lane = F.lane;
    bf16* WP1T = (bf16*)(a.ws + WS_WP1T); bf16* WOUTT = (bf16*)(a.ws + WS_WOUTT); bf16* WPOUTT = (bf16*)(a.ws + WS_WPOUTT);
    for (int it = gw; it < 3072; it += NGW) {
        if (it < 2048) { const int r = it & 1023, kb = r >> 5, nb = r & 31; const float* W = (it < 1024) ? a.attn_w_out : a.pool_w_out; bf16* T = (it < 1024) ? WOUTT : WPOUTT;
            transpose_tile(W + (size_t)(kb * 64) * DM + nb * 32, DM, T + (size_t)(nb * 32) * EW + kb * 64, EW, scr, lane); }
        else { const int r = it - 2048, kb = r >> 6, nb = r & 63;
            transpose_tile(a.pool_w_in + (size_t)(kb * 64) * 4096 + 2048 + nb * 32, 4096, WP1T + (size_t)(2048 + nb * 32) * DM + kb * 64, DM, scr, lane); }
    }
    typedef float f32x16 __attribute__((ext_vector_type(16)));
    for (int tile = gw; tile < 2048; tile += NGW) {
        const int g = tile >> 9, d0 = ((tile >> 5) & 15) * 32, k0 = (tile & 31) * 32;
        f32x16 acc = {};
        const float* ap = a.pool_w_grp + (size_t)g * 512 * 512 + (size_t)(lane >> 5) * 512 + d0 + (lane & 31);
        const float* bp = a.pool_w_in + (size_t)(k0 + (lane & 31)) * 4096 + g * 512 + (lane >> 5);
#pragma unroll 8
        for (int c0 = 0; c0 < 512; c0 += 2) { const float av = ap[(size_t)c0 * 512], bv = bp[c0]; acc = __builtin_amdgcn_mfma_f32_32x32x2f32(av, bv, acc, 0, 0, 0); }
#pragma unroll
        for (int r = 0; r < 16; ++r) { const int i = (r & 3) + 8 * (r >> 2) + 4 * (lane >> 5);
            WP1T[(size_t)(g * 512 + d0 + i) * DM + k0 + (lane & 31)] = (bf16)f2bf(acc[r]); }
    }
}

template <int LOGD, bool FIRST, bool LAST>
__device__ __forceinline__ void attn_naive(Frame& F, const Args& a) {
    constexpr int LOGL = 13 - LOGD, L = 1 << LOGL;
    const bf16* Qb = (const bf16*)(a.ws + WS_QKV); const bf16* Kb = Qb + (size_t)32 * 8192 * 128; const bf16* Vb = Kb + (size_t)32 * 8192 * 128;
    bf16* OA = (bf16*)a.out; float* LSE = (float*)(a.ws + WS_LSE); const bf16* SZ = (const bf16*)(a.ws + WS_SZ);
    LAS float* qs = (LAS float*)(F.lds + RING_OFF + F.wave * 2048); LAS float* ps = qs + 128;
    const int gw = F.vcu * NWAVES + F.wave, NGW = F.G * NWAVES, lane = F.lane;
    for (int R = gw; R < 32 * 8192; R += NGW) {
        const int bh = R >> 13, rem = R & 8191, r = rem >> LOGL, m = rem & (L - 1), t = (m << LOGD) + r, b = bh >> 4, h = bh & 15;
        { const unsigned u = *(const GAS unsigned*)(Qb + (size_t)R * 128 + 2 * lane); qs[2 * lane] = bf2f(u & 0xffffu); qs[2 * lane + 1] = bf2f(u >> 16); }
        LDS_WAIT(); asm volatile("" ::: "memory");
        const int nk = (m < 128 ? m : 128) + 1;
        float sc[3];
#pragma unroll
        for (int rd = 0; rd < 3; ++rd) {
            const int j = rd * 64 + lane; float s = -INFINITY;
            if (j < nk) { const GAS v4u* kr = (const GAS v4u*)(Kb + (size_t)(R - j) * 128); float acc = 0.f;
#pragma unroll 4
                for (int c = 0; c < 16; ++c) { const v4u w = kr[c];
                    acc += qs[8 * c + 0] * bf2f(w.x & 0xffffu) + qs[8 * c + 1] * bf2f(w.x >> 16) + qs[8 * c + 2] * bf2f(w.y & 0xffffu) + qs[8 * c + 3] * bf2f(w.y >> 16)
                         + qs[8 * c + 4] * bf2f(w.z & 0xffffu) + qs[8 * c + 5] * bf2f(w.z >> 16) + qs[8 * c + 6] * bf2f(w.w & 0xffffu) + qs[8 * c + 7] * bf2f(w.w >> 16); }
                s = acc * SM_SCALE; }
            sc[rd] = s; }
        const float mx = wave_max(fmaxf(fmaxf(sc[0], sc[1]), sc[2]));
        float den = 0.f;
#pragma unroll
        for (int rd = 0; rd < 3; ++rd) { const int j = rd * 64 + lane; const float p = (j < nk) ? exp2f((sc[rd] - mx) * LOG2E) : 0.f; den += p; ps[j] = p; }
        den = wave_sum(den);
        LDS_WAIT(); asm volatile("" ::: "memory");
        float o0 = 0.f, o1 = 0.f;
        for (int j = 0; j < nk; ++j) { const float pj = ps[j]; const unsigned u = *(const GAS unsigned*)(Vb + (size_t)(R - j) * 128 + 2 * lane); o0 += pj * bf2f(u & 0xffffu); o1 += pj * bf2f(u >> 16); }
        const float inv = 1.f / den; o0 *= inv; o1 *= inv;
        float L2 = mx * LOG2E + log2f(den);
        const size_t tok = (size_t)b * 8192 + t, oi = tok * 2048 + h * 128 + 2 * lane, li = tok * 16 + h;
        if (!FIRST) { const float La = LSE[li]; const unsigned u = *(const GAS unsigned*)(OA + oi); const float a0 = bf2f(u & 0xffffu), a1 = bf2f(u >> 16);
            const float Ln = fmaxf(La, L2), wa = exp2f(La - Ln), wb = exp2f(L2 - Ln), sw = wa + wb, is = 1.f / sw;
            o0 = (a0 * wa + o0 * wb) * is; o1 = (a1 * wa + o1 * wb) * is; L2 = Ln + log2f(sw); }
        if (LAST) { const unsigned z = *(const GAS unsigned*)(SZ + oi); o0 *= bf2f(z & 0xffffu); o1 *= bf2f(z >> 16); }
        *(GAS unsigned*)(OA + oi) = pk2(o0, o1);
        if (!LAST && lane == 0) LSE[li] = L2;
        LDS_WAIT(); asm volatile("" ::: "memory");
    }
}

__device__ __forceinline__ void p3_norm(Frame& F, const Args& a) {
    const int gw = F.vcu * NWAVES + F.wave, NGW = F.G * NWAVES, lane = F.lane;
    const float* T = (const float*)(a.ws + WS_V1); float* H1 = (float*)(a.ws + WS_H1); bf16* XN1 = (bf16*)(a.ws + WS_XN1);
    const GAS f32x4* gp = (const GAS f32x4*)(a.norm_post) + lane; const GAS f32x4* gq = (const GAS f32x4*)(a.norm_pre + DM) + lane;
    for (int m = gw; m < M; m += NGW) {
        const GAS f32x4* tr = (const GAS f32x4*)(T + (size_t)m * DM) + lane; const GAS f32x4* xr = (const GAS f32x4*)(a.x + (size_t)m * DM) + lane;
        f32x4 v[4]; float s = 0.f;
#pragma unroll
        for (int j = 0; j < 4; ++j) { v[j] = tr[64 * j]; s += (v[j].x * v[j].x + v[j].y * v[j].y) + (v[j].z * v[j].z + v[j].w * v[j].w); }
        const float r1 = 1.f / sqrtf(wave_sum(s) * (1.f / DM) + RMS_EPS); float s2 = 0.f;
        GAS f32x4* hr = (GAS f32x4*)(H1 + (size_t)m * DM) + lane;
#pragma unroll
        for (int j = 0; j < 4; ++j) { v[j] = xr[64 * j] + v[j] * r1 * gp[64 * j]; hr[64 * j] = v[j]; s2 += (v[j].x * v[j].x + v[j].y * v[j].y) + (v[j].z * v[j].z + v[j].w * v[j].w); }
        const float r2 = 1.f / sqrtf(wave_sum(s2) * (1.f / DM) + RMS_EPS);
        GAS unsigned long long* o8 = (GAS unsigned long long*)(XN1 + (size_t)m * DM) + lane;
#pragma unroll
        for (int j = 0; j < 4; ++j) { const f32x4 gg = gq[64 * j]; o8[64 * j] = (unsigned long long)pk2(v[j].x * r2 * gg.x, v[j].y * r2 * gg.y) | ((unsigned long long)pk2(v[j].z * r2 * gg.z, v[j].w * r2 * gg.w) << 32); }
    }
}
__device__ __forceinline__ void p5_pool(Frame& F, const Args& a) {
    const bf16* V1 = (const bf16*)(a.ws + WS_V1); const bf16* SZ1 = (const bf16*)(a.ws + WS_SZ1); bf16* Y2 = (bf16*)(a.ws + WS_Y2);
    for (int idx = F.vcu * 512 + F.tid; idx < M * 256; idx += F.G * 512) {
        const int row = idx >> 8, col0 = (idx & 255) * 8, g = col0 >> 9, w = 2 << g, t = row & 8191, cnt = (t + 1 < w) ? t + 1 : w;
        float sum[8], own[8];
#pragma unroll
        for (int e = 0; e < 8; ++e) sum[e] = 0.f;
        for (int j = 0; j < cnt; ++j) { const v4u q = *(const GAS v4u*)(V1 + (size_t)(row - j) * EW + col0);
            const float f[8] = {bf2f(q.x & 0xffffu), bf2f(q.x >> 16), bf2f(q.y & 0xffffu), bf2f(q.y >> 16), bf2f(q.z & 0xffffu), bf2f(q.z >> 16), bf2f(q.w & 0xffffu), bf2f(q.w >> 16)};
#pragma unroll
            for (int e = 0; e < 8; ++e) { sum[e] += f[e]; if (j == 0) own[e] = f[e]; } }
        const float ic = 1.f / (float)cnt;
        const v4u zq = *(const GAS v4u*)(SZ1 + (size_t)row * EW + col0);
        const float zf[8] = {bf2f(zq.x & 0xffffu), bf2f(zq.x >> 16), bf2f(zq.y & 0xffffu), bf2f(zq.y >> 16), bf2f(zq.z & 0xffffu), bf2f(zq.z >> 16), bf2f(zq.w & 0xffffu), bf2f(zq.w >> 16)};
        float y[8];
#pragma unroll
        for (int e = 0; e < 8; ++e) y[e] = ((sum[e] * ic - own[e]) + a.pool_b_grp[col0 + e]) * a.pool_scale[col0 + e] * zf[e];
        v4u o; o.x = pk2(y[0], y[1]); o.y = pk2(y[2], y[3]); o.z = pk2(y[4], y[5]); o.w = pk2(y[6], y[7]);
        *(GAS v4u*)(Y2 + (size_t)row * EW + col0) = o;
    }
}
__device__ __forceinline__ void p6_norm(Frame& F, const Args& a) {
    const int gw = F.vcu * NWAVES + F.wave, NGW = F.G * NWAVES, lane = F.lane;
    const float* T = (const float*)(a.ws + WS_SZ1); const float* H1 = (const float*)(a.ws + WS_H1);
    const GAS f32x4* gp = (const GAS f32x4*)(a.norm_post + DM) + lane;
    for (int m = gw; m < M; m += NGW) {
        const GAS f32x4* tr = (const GAS f32x4*)(T + (size_t)m * DM) + lane; const GAS f32x4* hr = (const GAS f32x4*)(H1 + (size_t)m * DM) + lane;
        f32x4 v[4]; float s = 0.f;
#pragma unroll
        for (int j = 0; j < 4; ++j) { v[j] = tr[64 * j]; s += (v[j].x * v[j].x + v[j].y * v[j].y) + (v[j].z * v[j].z + v[j].w * v[j].w); }
        const float r1 = 1.f / sqrtf(wave_sum(s) * (1.f / DM) + RMS_EPS);
        GAS f32x4* orow = (GAS f32x4*)(a.out + (size_t)m * DM) + lane;
#pragma unroll
        for (int j = 0; j < 4; ++j) orow[64 * j] = hr[64 * j] + v[j] * r1 * gp[64 * j];
    }
}

#ifndef MK_PER_PHASE
#define MK_PER_PHASE 0
#endif
constexpr int N_PHASES = 13;
__global__ void __launch_bounds__(NWAVES * 64, 2) skel_fwd(Args args) {
    extern __shared__ __attribute__((aligned(16))) unsigned char lds[];
    Frame F;
    F.lds = (LAS unsigned char*)lds;
    F.MISC = (volatile LAS unsigned*)(F.lds + MISC_OFF);
    F.tid = threadIdx.x; F.lane = F.tid & 63; F.wave = __builtin_amdgcn_readfirstlane(F.tid >> 6);
    F.G = gridDim.x; { const int bx = blockIdx.x; F.vcu = (F.G % 8 == 0) ? (bx % 8) * (F.G / 8) + bx / 8 : bx; }
    unsigned char* ws = args.ws;
    F.ctl = (gu32*)(ws + WS_CTL);
    for (int u = F.tid; u < (LDS_BYTES - LDSCTL_OFF) / 4; u += NWAVES * 64) ((LAS unsigned*)(F.lds + LDSCTL_OFF))[u] = 0u;
    __syncthreads();
    XcdBarrier bar; bar.bar = (unsigned*)(F.ctl + CW_BAR); bar.x = 0; bar.st = nullptr;
    if (!MK_PER_PHASE) bar = xcd_barrier_post((unsigned*)(F.ctl + CW_BAR), F.MISC + 8);
    const int lo = args.ph_lo, hi = args.ph_hi;
#define IN(k) (lo <= (k) && (k) < hi)
#define SEAM(k) do { if (IN(k) && IN((k) + 1)) xcd_barrier(bar); } while (0)
    bf16* XN0 = (bf16*)(ws + WS_XN0); bf16* Qb = (bf16*)(ws + WS_QKV); bf16* Kb = Qb + (size_t)32 * 8192 * 128; bf16* Vb = Kb + (size_t)32 * 8192 * 128;
    bf16* SZ = (bf16*)(ws + WS_SZ); const float* rope = (const float*)(ws + WS_ROPE);

    if (IN(0)) { p0_prologue(F, args); SEAM(0); }
    if (IN(1)) { pg8::Gemm g{XN0, (const bf16*)(ws + WS_WINT_A), M, NGRP, DM}; pg8::StaticOrder S; S.init(M, NGRP, F.G, (int)blockIdx.x);
        pg8::EpiQKV<0> E{Qb, SZ, rope};
        pg8::gemm_phase<pg8::EpiQKV<0>, pg8::StaticOrder, true, true>(F.lds + RING_OFF, g, S, E); SEAM(1); }
    if (IN(2)) { attn_naive<0, true, false>(F, args); SEAM(2); }
    if (IN(3)) { pg8::Gemm g{XN0, (const bf16*)(ws + WS_WINT_A) + (size_t)NGRP * DM, M, NGRP, DM}; pg8::StaticOrder S; S.init(M, NGRP, F.G, (int)blockIdx.x);
        pg8::EpiQKV<2> E{Qb, SZ, rope};
        pg8::gemm_phase<pg8::EpiQKV<2>, pg8::StaticOrder, true, true>(F.lds + RING_OFF, g, S, E); SEAM(3); }
    if (IN(4)) { attn_naive<2, false, false>(F, args); SEAM(4); }
    if (IN(5)) { pg8::Gemm g{XN0, (const bf16*)(ws + WS_WINT_B), M, NGRP + EW, DM}; pg8::StaticOrder S; S.init(M, NGRP + EW, F.G, (int)blockIdx.x);
        pg8::EpiQKV<4> E{Qb, SZ, rope};
        pg8::gemm_phase<pg8::EpiQKV<4>, pg8::StaticOrder, true, true>(F.lds + RING_OFF, g, S, E); SEAM(5); }
    if (IN(6)) { w1_prep(F, args); attn_naive<4, false, true>(F, args); SEAM(6); }
    if (IN(7)) { pg8::Gemm g{(const bf16*)args.out, (const bf16*)(ws + WS_WOUTT), M, DM, EW}; pg8::StaticOrder S; S.init(M, DM, F.G, (int)blockIdx.x);
        pg8::EpiF32 E{(float*)(ws + WS_V1), DM};
        pg8::gemm_phase<pg8::EpiF32, pg8::StaticOrder, true, true>(F.lds + RING_OFF, g, S, E); SEAM(7); }
    if (IN(8)) { p3_norm(F, args); SEAM(8); }
    if (IN(9)) { pg8::Gemm g{(const bf16*)(ws + WS_XN1), (const bf16*)(ws + WS_WP1T), M, 2 * EW, DM}; pg8::StaticOrder S; S.init(M, 2 * EW, F.G, (int)blockIdx.x);
        pg8::EpiVZ E{(bf16*)(ws + WS_V1), (bf16*)(ws + WS_SZ1)};
        pg8::gemm_phase<pg8::EpiVZ, pg8::StaticOrder, true, true>(F.lds + RING_OFF, g, S, E); SEAM(9); }
    if (IN(10)) { p5_pool(F, args); SEAM(10); }
    if (IN(11)) { pg8::Gemm g{(const bf16*)(ws + WS_Y2), (const bf16*)(ws + WS_WPOUTT), M, DM, EW}; pg8::StaticOrder S; S.init(M, DM, F.G, (int)blockIdx.x);
        pg8::EpiF32 E{(float*)(ws + WS_SZ1), DM};
        pg8::gemm_phase<pg8::EpiF32, pg8::StaticOrder, true, true>(F.lds + RING_OFF, g, S, E); SEAM(11); }
    if (IN(12)) { p6_norm(F, args); }
#undef IN
#undef SEAM
}

extern "C" void kernel_launch(void* const* d_in, const int* in_sizes, int n_in, void* d_out, int out_size, void* d_ws, size_t ws_size, hipStream_t stream) {
    static int grid = 0;
    if (grid == 0) {
        if (n_in != 11 || in_sizes[0] != M * DM || out_size != M * DM || ws_size < WS_END) {
            fprintf(stderr, "kernel_launch: shape/workspace mismatch: n_in %d in0 %d out %d ws %zu (need %zu); nothing launched\n", n_in, n_in > 0 ? in_sizes[0] : -1, out_size, ws_size, (size_t)WS_END); grid = -1; return; }
        int dev = 0, cus = 0, per_cu = 0;
        if (hipGetDevice(&dev) != hipSuccess || hipDeviceGetAttribute(&cus, hipDeviceAttributeMultiprocessorCount, dev) != hipSuccess) { grid = -1; return; }
        if (hipFuncSetAttribute((const void*)skel_fwd, hipFuncAttributeMaxDynamicSharedMemorySize, LDS_BYTES) != hipSuccess) { fprintf(stderr, "kernel_launch: hipFuncSetAttribute failed\n"); grid = -1; return; }
        if (hipOccupancyMaxActiveBlocksPerMultiprocessor(&per_cu, (const void*)skel_fwd, NWAVES * 64, LDS_BYTES) != hipSuccess || per_cu < 1) {
            fprintf(stderr, "kernel_launch: occupancy query reports %d workgroups per CU\n", per_cu); }
        (void)hipGetLastError();
        grid = cus;
    }
    if (grid < 0) return;
    if (hipMemsetAsync((char*)d_ws + WS_CTL, 0, CTL_ZERO_BYTES, stream) != hipSuccess) { fprintf(stderr, "kernel_launch: hipMemsetAsync failed\n"); return; }
    Args a{};
    a.x = (const float*)d_in[0]; a.pos = (const int*)d_in[1]; a.norm_pre = (const float*)d_in[2]; a.norm_post = (const float*)d_in[3];
    a.attn_w_in = (const float*)d_in[4]; a.attn_w_out = (const float*)d_in[5]; a.pool_w_in = (const float*)d_in[6]; a.pool_w_grp = (const float*)d_in[7];
    a.pool_b_grp = (const float*)d_in[8]; a.pool_scale = (const float*)d_in[9]; a.pool_w_out = (const float*)d_in[10];
    a.out = (float*)d_out; a.ws = (unsigned char*)d_ws;
#if MK_PER_PHASE
    for (int p = 0; p < N_PHASES; ++p) { a.ph_lo = p; a.ph_hi = p + 1; a.li = p;
        hipLaunchKernelGGL(skel_fwd, dim3(grid), dim3(NWAVES * 64), LDS_BYTES, stream, a);
        const hipError_t le = hipPeekAtLastError(); if (le != hipSuccess) { fprintf(stderr, "kernel_launch: launch %d failed: %s\n", p, hipGetErrorName(le)); break; } }
#else
    a.ph_lo = 0; a.ph_hi = N_PHASES; a.li = 0;
    hipLaunchKernelGGL(skel_fwd, dim3(grid), dim3(NWAVES * 64), LDS_BYTES, stream, a);
    const hipError_t le = hipPeekAtLastError(); if (le != hipSuccess) fprintf(stderr, "kernel_launch: launch failed: %s\n", hipGetErrorName(le));
#endif
}
```

```cpp
#include <hip/hip_runtime.h>
#include <cstdio>
#include <cstdint>
#include <cmath>
namespace pg8 {
#define PG8_LAS __attribute__((address_space(3)))
typedef unsigned short bf16_t;
typedef short bf16x8 __attribute__((ext_vector_type(8)));
typedef float f32x4 __attribute__((ext_vector_type(4)));
typedef unsigned u32x4 __attribute__((ext_vector_type(4)));
constexpr int BM = 256, BK = 64, HALF = 128, HTB = HALF * BK * 2  , STAGE_BYTES = 8 * HTB, NXCD = 8, WGM = 8;

__host__ __device__ __forceinline__ int lds_byte(int r, int c) { const int st = (r >> 4) * 2 + (c >> 5), rr = r & 15, cc = c & 31, ob = rr * 64 + cc * 2; return st * 1024 + (ob ^ (((ob >> 9) & 1) << 5)); }
__host__ __device__ __forceinline__ void stage_rc(int b, int& R, int& C) { const int st = b / 1024, sb = b % 1024, swz = sb ^ (((sb >> 9) & 1) << 5); R = (st >> 1) * 16 + swz / 64; C = (st & 1) * 32 + (swz % 64) / 2; }
__host__ __device__ __forceinline__ int perm32(int rho) { const int n = rho >> 4, i = rho & 15; return 8 * (i >> 2) + 4 * n + (i & 3); }

struct Unit { int pm, pn; };
struct Gemm { const bf16_t* A; const bf16_t* Bt; int M, N, K; };

struct StaticOrder {
    int nM, nN, nwg, G, c;
    __host__ __device__ void init(int M, int N, int G_, int c_) { nM = M / BM; nN = N / BM; nwg = nM * nN; G = G_; c = c_; }
    __host__ __device__ bool next(int i, Unit& u) const {
        const long L = (long)i * G + c; if (L >= nwg) return false;
        int wgid = (int)L; { const int q = nwg / NXCD, r = nwg % NXCD, xcd = wgid % NXCD, off = wgid / NXCD; wgid = (xcd < r ? xcd * (q + 1) : r * (q + 1) + (xcd - r) * q) + off; }
        const int nig = WGM * nN, gid = wgid / nig, fm = gid * WGM, gsz = (nM - fm) < WGM ? (nM - fm) : WGM;
        u.pm = fm + ((wgid % nig) % gsz); u.pn = (wgid % nig) / gsz; return true;
    }
    __device__ __forceinline__ void a_ready(const Unit&) const {}
    __device__ __forceinline__ void done(const Unit&) const {}
};

__device__ __forceinline__ unsigned cvt_pk_bf16(float lo, float hi) { unsigned r; asm volatile("v_cvt_pk_bf16_f32 %0, %1, %2" : "=v"(r) : "v"(lo), "v"(hi)); return r; }
typedef float f32x2 __attribute__((ext_vector_type(2)));
typedef unsigned u32x2 __attribute__((ext_vector_type(2)));
__device__ __forceinline__ float silu_f(float v) { return v * __builtin_amdgcn_rcpf(1.0f + __builtin_amdgcn_exp2f(-1.4426950408889634f * v)); }

struct EpiF32 {
    static constexpr bool PERM = false, AFTER_DRAIN = false;
    float* C; int ldc;
    __device__ __forceinline__ void operator()(const f32x4 (&acc)[2][2][4][2], const Unit& u, int wr, int wc, int fr, int fq) const {
        const int row0 = u.pm * BM + wr * 64 + fr, col0 = u.pn * BM + wc * 32 + 4 * fq;
#pragma unroll
        for (int ai = 0; ai < 2; ++ai)
#pragma unroll
            for (int m = 0; m < 4; ++m) { float* rowp = C + (size_t)(row0 + ai * HALF + m * 16) * ldc + col0;
#pragma unroll
                for (int bj = 0; bj < 2; ++bj)
#pragma unroll
                    for (int n = 0; n < 2; ++n) *(f32x4*)(rowp + bj * HALF + n * 16) = acc[ai][bj][m][n]; }
    }
};

struct EpiVZ {
    static constexpr bool PERM = true, AFTER_DRAIN = false;
    bf16_t* V; bf16_t* SZ;
    __device__ __forceinline__ void operator()(const f32x4 (&acc)[2][2][4][2], const Unit& u, int wr, int wc, int fr, int fq) const {
        const int row0 = u.pm * BM + wr * 64 + fr; const bool isz = u.pn >= 8;
        bf16_t* base = isz ? SZ : V; const int col0 = (isz ? u.pn - 8 : u.pn) * BM + wc * 32 + 8 * fq;
#pragma unroll
        for (int ai = 0; ai < 2; ++ai)
#pragma unroll
            for (int m = 0; m < 4; ++m) { bf16_t* rowp = base + (size_t)(row0 + ai * HALF + m * 16) * 2048 + col0;
#pragma unroll
                for (int bj = 0; bj < 2; ++bj) { f32x4 v0 = acc[ai][bj][m][0], v1 = acc[ai][bj][m][1];
                    if (isz) { v0 = (f32x4){silu_f(v0[0]), silu_f(v0[1]), silu_f(v0[2]), silu_f(v0[3])}; v1 = (f32x4){silu_f(v1[0]), silu_f(v1[1]), silu_f(v1[2]), silu_f(v1[3])}; }
                    u32x4 w; w.x = cvt_pk_bf16(v0[0], v0[1]); w.y = cvt_pk_bf16(v0[2], v0[3]); w.z = cvt_pk_bf16(v1[0], v1[1]); w.w = cvt_pk_bf16(v1[2], v1[3]);
                    *(u32x4*)(rowp + bj * HALF) = w; } }
    }
};

template <int LOGD> struct EpiQKV {
    static constexpr bool PERM = true, AFTER_DRAIN = false;
    bf16_t* QKV; bf16_t* SZ; const float* rope;
    __device__ __forceinline__ void operator()(const f32x4 (&acc)[2][2][4][2], const Unit& u, int wr, int wc, int fr, int fq) const {
        constexpr int LOGL = 13 - LOGD, DM1 = (1 << LOGD) - 1;
        const int row0 = u.pm * BM + wr * 64 + fr;
        if (u.pn >= 24) {
            const int col0 = (u.pn - 24) * BM + wc * 32 + 8 * fq;
#pragma unroll
            for (int ai = 0; ai < 2; ++ai)
#pragma unroll
                for (int m = 0; m < 4; ++m) { bf16_t* rowp = SZ + (size_t)(row0 + ai * HALF + m * 16) * 2048 + col0;
#pragma unroll
                    for (int bj = 0; bj < 2; ++bj) { const f32x4 v0 = acc[ai][bj][m][0], v1 = acc[ai][bj][m][1];
                        u32x4 w; w.x = cvt_pk_bf16(silu_f(v0[0]), silu_f(v0[1])); w.y = cvt_pk_bf16(silu_f(v0[2]), silu_f(v0[3]));
                        w.z = cvt_pk_bf16(silu_f(v1[0]), silu_f(v1[1])); w.w = cvt_pk_bf16(silu_f(v1[2]), silu_f(v1[3]));
                        *(u32x4*)(rowp + bj * HALF) = w; } }
            return;
        }
        const int c = u.pn >> 3, hp = u.pn & 7;
        bf16_t* base = QKV + (size_t)c * ((size_t)32 * 8192 * 128);
        const bool rot = (c < 2) && (wc == 0);
        const float sgn = (fq < 2) ? -1.f : 1.f;
#pragma unroll
        for (int ai = 0; ai < 2; ++ai)
#pragma unroll
            for (int m = 0; m < 4; ++m) {
                const int row = row0 + ai * HALF + m * 16, b = row >> 13, t = row & 8191;
                const int srow = ((t & DM1) << LOGL) + (t >> LOGD);
                f32x4 cs0, cs1, sn0, sn1;
                if (rot) { const float* rp = rope + (size_t)row * 32 + 8 * (fq & 1);
                    cs0 = *(const f32x4*)rp; cs1 = *(const f32x4*)(rp + 4); sn0 = *(const f32x4*)(rp + 16); sn1 = *(const f32x4*)(rp + 20); }
#pragma unroll
                for (int bj = 0; bj < 2; ++bj) {
                    f32x4 v0 = acc[ai][bj][m][0], v1 = acc[ai][bj][m][1];
                    if (rot) {
                        f32x4 p0, p1;
#pragma unroll
                        for (int j = 0; j < 4; ++j) { p0[j] = __shfl_xor(v0[j], 32); p1[j] = __shfl_xor(v1[j], 32); }
                        v0 = v0 * cs0 + (p0 * sn0) * sgn; v1 = v1 * cs1 + (p1 * sn1) * sgn;
                    }
                    const int h = hp * 2 + bj;
                    bf16_t* dst = base + ((size_t)((b * 16 + h) << 13) + srow) * 128 + wc * 32 + 8 * fq;
                    u32x4 w; w.x = cvt_pk_bf16(v0[0], v0[1]); w.y = cvt_pk_bf16(v0[2], v0[3]); w.z = cvt_pk_bf16(v1[0], v1[1]); w.w = cvt_pk_bf16(v1[2], v1[3]);
                    *(u32x4*)dst = w;
                }
            }
    }
};
template <class Epi, class Sched, bool ALIGN_EPI = false, bool SP2 = false>
__device__ __forceinline__ void gemm_phase(PG8_LAS unsigned char* lds, const Gemm g, const Sched& S, const Epi& E) {
    const int tid = threadIdx.x, wid = __builtin_amdgcn_readfirstlane(tid >> 6), lane = tid & 63, wr = wid >> 2, wc = wid & 3, fr = lane & 15, fq = lane >> 4;
    const int K = g.K, nt = K / BK;
    unsigned voffA[2], voffB[2];
#pragma unroll
    for (int i = 0; i < 2; ++i) { int R, C; stage_rc(tid * 16 + i * 8192, R, C); const int Rb = Epi::PERM ? ((R & ~31) + perm32(R & 31)) : R;
        voffA[i] = (unsigned)(R * K + C) * 2u; voffB[i] = (unsigned)(Rb * K + C) * 2u; }
    const size_t kstep = (size_t)(BK * 2);
    const size_t hstep = (size_t)HALF * K * 2;
    const size_t tstep = 2 * hstep;
    const unsigned ldsw = (unsigned)wid * 1024u;
    const int aoff = lds_byte(wr * 64 + fr, fq * 8), boff = lds_byte(wc * 32 + fr, fq * 8);
#define PG8_SA(b, h) (((b) * 2 + (h)) * HTB)
#define PG8_SB(b, h) ((4 + (b) * 2 + (h)) * HTB)
#define PG8_STAGE(bufoff, gbase, voff) do { _Pragma("unroll") for (int _i = 0; _i < 2; ++_i) \
        __builtin_amdgcn_global_load_lds((const unsigned*)((const char*)(gbase) + (voff)[_i]), (PG8_LAS unsigned*)(lds + (bufoff) + ldsw + _i * 8192), 16, 0, 0); } while (0)
#define PG8_LDA(dst, b, h) do { _Pragma("unroll") for (int m = 0; m < 4; ++m) _Pragma("unroll") for (int k = 0; k < 2; ++k) dst[m][k] = *(const PG8_LAS bf16x8*)(lds + PG8_SA(b, h) + aoff + m * 2048 + k * 1024); } while (0)
#define PG8_LDB(dst, b, h) do { _Pragma("unroll") for (int n = 0; n < 2; ++n) _Pragma("unroll") for (int k = 0; k < 2; ++k) dst[n][k] = *(const PG8_LAS bf16x8*)(lds + PG8_SB(b, h) + boff + n * 2048 + k * 1024); } while (0)
#define PG8_MMA(ai, bj, At, Bt) do { __builtin_amdgcn_s_setprio(1); _Pragma("unroll") for (int m = 0; m < 4; ++m) _Pragma("unroll") for (int n = 0; n < 2; ++n) _Pragma("unroll") for (int k = 0; k < 2; ++k) \
        acc[ai][bj][m][n] = __builtin_amdgcn_mfma_f32_16x16x32_bf16(Bt[n][k], At[m][k], acc[ai][bj][m][n], 0, 0, 0); __builtin_amdgcn_s_setprio(0); } while (0)
#define PG8_WAIT_V(n) asm volatile("s_waitcnt vmcnt(" #n ")" ::: "memory")
#define PG8_WAIT_L(n) asm volatile("s_waitcnt lgkmcnt(" #n ")" ::: "memory")
#define PG8_BAR __builtin_amdgcn_s_barrier()
#define PG8_SCHED __builtin_amdgcn_sched_barrier(0)
    Unit cur, nxt; int ui = 0;
    if (!S.next(0, cur)) return;
    f32x4 acc[2][2][4][2];
#pragma unroll
    for (int a = 0; a < 2; ++a)
#pragma unroll
        for (int b = 0; b < 2; ++b)
#pragma unroll
            for (int m = 0; m < 4; ++m)
#pragma unroll
                for (int n = 0; n < 2; ++n) acc[a][b][m][n] = (f32x4){0.f, 0.f, 0.f, 0.f};
    bf16x8 At[4][2], B0[2][2], B1[2][2];
    const char* cA = (const char*)g.A + (size_t)cur.pm * tstep; const char* cB = (const char*)g.Bt + (size_t)cur.pn * tstep;
    S.a_ready(cur);
    if constexpr (SP2) {
        PG8_STAGE(PG8_SB(0, 0), cB, voffB); PG8_STAGE(PG8_SB(0, 1), cB + hstep, voffB); PG8_STAGE(PG8_SA(0, 0), cA, voffA); PG8_STAGE(PG8_SA(0, 1), cA + hstep, voffA);
        if (wr == 1) PG8_BAR;
        PG8_WAIT_V(2); PG8_BAR;
        PG8_STAGE(PG8_SB(1, 0), cB + kstep, voffB); PG8_STAGE(PG8_SA(1, 0), cA + kstep, voffA); PG8_STAGE(PG8_SB(1, 1), cB + hstep + kstep, voffB);
        PG8_WAIT_V(6); PG8_BAR;
    } else {
        PG8_STAGE(PG8_SB(0, 0), cB, voffB); PG8_STAGE(PG8_SA(0, 0), cA, voffA); PG8_STAGE(PG8_SB(0, 1), cB + hstep, voffB); PG8_STAGE(PG8_SA(0, 1), cA + hstep, voffA);
        if (wr == 1) PG8_BAR;
        PG8_WAIT_V(4); PG8_BAR;
        PG8_STAGE(PG8_SB(1, 0), cB + kstep, voffB); PG8_STAGE(PG8_SA(1, 0), cA + kstep, voffA); PG8_STAGE(PG8_SB(1, 1), cB + hstep + kstep, voffB);
        PG8_WAIT_V(6); PG8_BAR;
    }
    for (;;) {
        const bool has_next = S.next(ui + 1, nxt);
        const char* nA = has_next ? (const char*)g.A + (size_t)nxt.pm * tstep : cA; const char* nB = has_next ? (const char*)g.Bt + (size_t)nxt.pn * tstep : cB;
        for (int t = 0; t < nt; t += 2) {
            const bool last = (t == nt - 2);
            const char* a1 = cA + (size_t)(t + 1) * kstep;
            const char* a2 = last ? nA : cA + (size_t)(t + 2) * kstep; const char* b2 = last ? nB : cB + (size_t)(t + 2) * kstep;
            const char* a3 = a2 + kstep; const char* b3 = b2 + kstep;
            if (last && has_next) S.a_ready(nxt);
            if constexpr (SP2) {
            PG8_LDB(B0, 0, 0); PG8_LDB(B1, 0, 1); PG8_SCHED; PG8_LDA(At, 0, 0); PG8_STAGE(PG8_SA(1, 1), a1 + hstep, voffA);
            PG8_WAIT_V(8); PG8_WAIT_L(0); PG8_BAR; PG8_MMA(0, 0, At, B0); PG8_MMA(0, 1, At, B1); PG8_BAR; PG8_SCHED;
            PG8_LDA(At, 0, 1); PG8_STAGE(PG8_SB(0, 0), b2, voffB); PG8_STAGE(PG8_SB(0, 1), b2 + hstep, voffB); PG8_STAGE(PG8_SA(0, 0), a2, voffA);
            PG8_WAIT_V(8); PG8_WAIT_L(0); PG8_BAR; PG8_MMA(1, 0, At, B0); PG8_MMA(1, 1, At, B1); PG8_BAR; PG8_SCHED;
            PG8_LDB(B0, 1, 0); PG8_LDB(B1, 1, 1); PG8_SCHED; PG8_LDA(At, 1, 0); PG8_STAGE(PG8_SA(0, 1), a2 + hstep, voffA);
            PG8_WAIT_V(8); PG8_WAIT_L(0); PG8_BAR; PG8_MMA(0, 0, At, B0); PG8_MMA(0, 1, At, B1); PG8_BAR; PG8_SCHED;
            PG8_LDA(At, 1, 1); PG8_STAGE(PG8_SB(1, 0), b3, voffB); PG8_STAGE(PG8_SB(1, 1), b3 + hstep, voffB); PG8_STAGE(PG8_SA(1, 0), a3, voffA);
            PG8_WAIT_V(8); PG8_WAIT_L(0); PG8_BAR; PG8_MMA(1, 0, At, B0); PG8_MMA(1, 1, At, B1); PG8_BAR; PG8_SCHED;
            } else {
            PG8_LDB(B0, 0, 0); PG8_SCHED; PG8_LDA(At, 0, 0); PG8_STAGE(PG8_SA(1, 1), a1 + hstep, voffA);
            PG8_WAIT_L(8); PG8_BAR; PG8_WAIT_L(0); PG8_MMA(0, 0, At, B0); PG8_BAR; PG8_SCHED;
            PG8_LDB(B1, 0, 1); PG8_STAGE(PG8_SB(0, 0), b2, voffB);
            PG8_BAR; PG8_WAIT_L(0); PG8_MMA(0, 1, At, B1); PG8_BAR;
            PG8_LDA(At, 0, 1); PG8_STAGE(PG8_SA(0, 0), a2, voffA);
            PG8_BAR; PG8_WAIT_L(0); PG8_MMA(1, 0, At, B0); PG8_BAR; PG8_SCHED;
            PG8_STAGE(PG8_SB(0, 1), b2 + hstep, voffB);
            PG8_WAIT_V(6); PG8_BAR; PG8_MMA(1, 1, At, B1); PG8_BAR;
            PG8_LDB(B0, 1, 0); PG8_SCHED; PG8_LDA(At, 1, 0); PG8_STAGE(PG8_SA(0, 1), a2 + hstep, voffA);
            PG8_WAIT_L(8); PG8_BAR; PG8_WAIT_L(0); PG8_MMA(0, 0, At, B0); PG8_BAR; PG8_SCHED;
            PG8_LDB(B1, 1, 1); PG8_STAGE(PG8_SB(1, 0), b3, voffB);
            PG8_BAR; PG8_WAIT_L(0); PG8_MMA(0, 1, At, B1); PG8_BAR;
            PG8_LDA(At, 1, 1); PG8_STAGE(PG8_SA(1, 0), a3, voffA);
            PG8_BAR; PG8_WAIT_L(0); PG8_MMA(1, 0, At, B0); PG8_BAR; PG8_SCHED;
            PG8_STAGE(PG8_SB(1, 1), b3 + hstep, voffB);
            PG8_WAIT_V(6); PG8_BAR; PG8_MMA(1, 1, At, B1); PG8_BAR;
            }
        }
        if constexpr (ALIGN_EPI) { if (wr == 0) PG8_BAR; }
        if constexpr (!Epi::AFTER_DRAIN) { E(acc, cur, wr, wc, fr, fq); S.done(cur); }
        if (!has_next) break;
#pragma unroll
        for (int a = 0; a < 2; ++a)
#pragma unroll
            for (int b = 0; b < 2; ++b)
#pragma unroll
                for (int m = 0; m < 4; ++m)
#pragma unroll
                    for (int n = 0; n < 2; ++n) acc[a][b][m][n] = (f32x4){0.f, 0.f, 0.f, 0.f};
        cur = nxt; cA = nA; cB = nB; ++ui;
        if constexpr (ALIGN_EPI) { if (wr == 1) PG8_BAR; }
    }
    PG8_WAIT_V(0);
    if constexpr (!ALIGN_EPI) { if (wr == 0) PG8_BAR; }
    PG8_BAR;
    if constexpr (Epi::AFTER_DRAIN) { E.fused(acc, cur, wr, wc, fr, fq, lds, wid, lane); S.done(cur); }
#undef PG8_SA
#undef PG8_SB
#undef PG8_STAGE
#undef PG8_LDA
#undef PG8_LDB
#undef PG8_MMA
#undef PG8_WAIT_V
#undef PG8_WAIT_L
#undef PG8_BAR
#undef PG8_SCHED
}
}
#define GAS __attribute__((address_space(1)))
#define LAS __attribute__((address_space(3)))
typedef unsigned short bf16;
typedef unsigned v4u __attribute__((ext_vector_type(4)));
typedef float f32x4 __attribute__((ext_vector_type(4)));
typedef short bf16x8 __attribute__((ext_vector_type(8)));
typedef GAS unsigned gu32;
typedef GAS unsigned long long gu64;
#define RLX_AGENT __ATOMIC_RELAXED, __HIP_MEMORY_SCOPE_AGENT
#define LDS_WAIT() asm volatile("s_waitcnt lgkmcnt(0)" ::: "memory")
#define VM_WAIT() asm volatile("s_waitcnt vmcnt(0)" ::: "memory")
__device__ __forceinline__ unsigned long long rt() { return __builtin_amdgcn_s_memrealtime(); }
__device__ __forceinline__ unsigned f2bf(float f) { unsigned u = __builtin_bit_cast(unsigned, f); return (u + 0x7fffu + ((u >> 16) & 1u)) >> 16; }
__device__ __forceinline__ unsigned pk2(float lo, float hi) { return f2bf(lo) | (f2bf(hi) << 16); }

#define XB_TMO      128
#define XB_XCNT(j)  (256  + 64 * (j))
#define XB_XSUB(j)  (1280 + 64 * (j))
#define XB_XGEN(j)  (2304 + 64 * (j))
#define XB_TOP      3328
#define XB_TOPGEN   3392
#define XCD_BAR_WORDS 3456
#define XB_SPIN_CAP (1u << 18)

__device__ __forceinline__ unsigned xb_ld(unsigned* p)              { return __hip_atomic_load(p, __ATOMIC_RELAXED, __HIP_MEMORY_SCOPE_AGENT); }
__device__ __forceinline__ unsigned xb_add(unsigned* p, unsigned v) { return __hip_atomic_fetch_add(p, v, __ATOMIC_RELAXED, __HIP_MEMORY_SCOPE_AGENT); }
__device__ __forceinline__ unsigned xb_xcc_id() { return (unsigned)__builtin_amdgcn_s_getreg((3 << 11) | 20) & 0xFu; }
#define XB_SPIN(cond, bar) do { unsigned _sp = 0; while (cond) { __builtin_amdgcn_s_sleep(1); \
    if ((++_sp & 255u) == 0u) { if (xb_ld(&(bar)[XB_TMO])) break; if (_sp > XB_SPIN_CAP) { atomicAdd(&(bar)[XB_TMO], 1u); break; } } } } while (0)

struct XcdBarrier {
    unsigned* bar; unsigned x;
    volatile LAS unsigned* st;
};

__device__ __forceinline__ XcdBarrier xcd_barrier_post(unsigned* bar, volatile LAS unsigned* st) {
    XcdBarrier b; b.bar = bar; b.x = xb_xcc_id(); b.st = st;
    if (threadIdx.x == 0) (void)xb_add(&bar[XB_XCNT(b.x)], 1u);
    return b;
}
__device__ __forceinline__ void xcd_barrier_complete(unsigned* bar, unsigned x, unsigned& nloc, unsigned& nx) {
    const unsigned G = gridDim.x * gridDim.y * gridDim.z;
    unsigned sum, cnt, mine, sp = 0u;
    for (;;) {
        sum = 0u; cnt = 0u; mine = 0u;
#pragma unroll
        for (unsigned j = 0; j < 16; ++j) { const unsigned c = xb_ld(&bar[XB_XCNT(j)]); sum += c; cnt += (c > 0u) ? 1u : 0u; mine = (j == x) ? c : mine; }
        if (sum == G) break;
        __builtin_amdgcn_s_sleep(1);
        if ((++sp & 255u) == 0u) { if (xb_ld(&bar[XB_TMO])) break; if (sp > XB_SPIN_CAP) { atomicAdd(&bar[XB_TMO], 1u); break; } }
    }
    nloc = mine > 0u ? mine : 1u; nx = cnt > 0u ? cnt : 1u;
}

__device__ __forceinline__ void xcd_barrier(const XcdBarrier& b) {
    asm volatile("s_waitcnt vmcnt(0)" ::: "memory");
    __syncthreads();
    if (threadIdx.x == 0) {
        unsigned* bar = b.bar;
        __builtin_amdgcn_s_waitcnt(0);
        unsigned nloc = b.st[0], nx = b.st[1];
        if (nloc == 0u) { xcd_barrier_complete(bar, b.x, nloc, nx); b.st[0] = nloc; b.st[1] = nx; }
        const unsigned old = xb_add(&bar[XB_XSUB(b.x)], 1u);
        const unsigned gen = old / nloc;
        if (old + 1u == (gen + 1u) * nloc) {
            __builtin_amdgcn_fence(__ATOMIC_RELEASE, "agent");
            asm volatile("s_waitcnt vmcnt(0)" ::: "memory");
            const unsigned og = xb_add(&bar[XB_TOP], 1u);
            const unsigned tg = og / nx;
            if (og + 1u == (tg + 1u) * nx) xb_add(&bar[XB_TOPGEN], 1u);
            else XB_SPIN(xb_ld(&bar[XB_TOPGEN]) == tg, bar);
            __builtin_amdgcn_fence(__ATOMIC_ACQUIRE, "agent");
            xb_add(&bar[XB_XGEN(b.x)], 1u);
            asm volatile("s_waitcnt vmcnt(0)" ::: "memory");
        } else {
            XB_SPIN(xb_ld(&bar[XB_XGEN(b.x)]) == gen, bar);
            __builtin_amdgcn_fence(__ATOMIC_ACQUIRE, "agent");
            asm volatile("s_waitcnt vmcnt(0)" ::: "memory");
        }
    }
    __syncthreads();
}

constexpr int NWAVES = 8;
constexpr int BATCH = 2, SEQ = 8192, DM = 1024, EW = 2048, NHEAD = 16, HD = 128;
constexpr int M = BATCH * SEQ;
constexpr int NIN = 3 * 3 * EW + EW;
constexpr int NGRP = 3 * EW;
constexpr float RMS_EPS = 1e-6f;
constexpr float SM_SCALE = 0.08838834764831845f;
constexpr float LOG2E = 1.4426950408889634f;

constexpr size_t MiB = 1u << 20;
constexpr size_t WS_CTL = 0, CTL_ZERO_BYTES = 256 * 1024;
constexpr size_t WS_XN0  = 1 * MiB;
constexpr size_t WS_QKV  = 33 * MiB;
constexpr size_t WS_SZ   = 225 * MiB;
constexpr size_t WS_WINT_A = 225 * MiB;
constexpr size_t WS_WINT_B = 289 * MiB;
constexpr size_t WS_ROPE = 305 * MiB;
constexpr size_t WS_LSE  = 307 * MiB;
constexpr size_t WS_WP1T  = 1 * MiB;
constexpr size_t WS_WOUTT = 9 * MiB;
constexpr size_t WS_WPOUTT = 13 * MiB;
constexpr size_t WS_H1  = 17 * MiB;
constexpr size_t WS_XN1 = 81 * MiB;
constexpr size_t WS_V1  = 113 * MiB;
constexpr size_t WS_SZ1 = 177 * MiB;
constexpr size_t WS_Y2  = 241 * MiB;
constexpr size_t WS_END = 320 * MiB;
constexpr int CW_TMO = 0, CW_CODE = 1, CW_BAR = 4096;

constexpr int RING_OFF = 0, RING_BYTES = 139264;
constexpr int LDSCTL_OFF = RING_BYTES, MISC_OFF = LDSCTL_OFF + 320;
constexpr int LDS_BYTES = 147456;

struct Frame {
    LAS unsigned char* lds;
    volatile LAS unsigned* MISC;
    gu32* ctl;
    int wave;
    int vcu, G;
};
struct Args {
    const float* x; const int* pos; const float* norm_pre; const float* norm_post; const float* attn_w_in; const float* attn_w_out;
    const float* pool_w_in; const float* pool_w_grp; const float* pool_b_grp; const float* pool_scale; const float* pool_w_out;
    float* out; unsigned char* ws; float inv_freq[16]; int ph_lo, ph_hi, li, pad;
};

__device__ __forceinline__ int tid_now() { int t = threadIdx.x; asm volatile("" : "+v"(t)); return t; }
__device__ __forceinline__ float wave_sum(float v) {
#pragma unroll
    for (int o = 1; o < 64; o <<= 1) v += __shfl_xor(v, o);
    return v;
}
__device__ __forceinline__ float wave_max(float v) {
#pragma unroll
    for (int o = 1; o < 64; o <<= 1) v = fmaxf(v, __shfl_xor(v, o));
    return v;
}
__device__ __forceinline__ float bf2f(unsigned short h) { return __uint_as_float(((unsigned)h) << 16); }

__device__ __forceinline__ void transpose_tile(const float* src, int ldw, bf16* dst, int ldt, LAS float* scr, int lane) {
#pragma unroll 8
    for (int i = 0; i < 32; ++i) { const int kk = 2 * i + (lane >> 5); scr[kk * 33 + (lane & 31)] = src[(size_t)kk * ldw + (lane & 31)]; }
    LDS_WAIT(); asm volatile("" ::: "memory");
    const int c = lane & 7;
#pragma unroll
    for (int j = 0; j < 4; ++j) { const int n = (lane >> 3) + 8 * j; const LAS float* s = scr + (8 * c) * 33 + n;
        v4u o; o.x = pk2(s[0 * 33], s[1 * 33]); o.y = pk2(s[2 * 33], s[3 * 33]); o.z = pk2(s[4 * 33], s[5 * 33]); o.w = pk2(s[6 * 33], s[7 * 33]);
        *(GAS v4u*)(dst + (size_t)n * ldt + 8 * c) = o; }
    LDS_WAIT(); asm volatile("" ::: "memory");
}
__device__ __forceinline__ void rms_row_to_bf16(const float* xrow, const float* g, bf16* orow, int lane) {
    const GAS f32x4* xr = (const GAS f32x4*)xrow + lane; const GAS f32x4* gr = (const GAS f32x4*)g + lane;
    f32x4 v[4]; float s = 0.f;
#pragma unroll
    for (int j = 0; j < 4; ++j) { v[j] = xr[64 * j]; s += (v[j].x * v[j].x + v[j].y * v[j].y) + (v[j].z * v[j].z + v[j].w * v[j].w); }
    const float r = 1.f / sqrtf(wave_sum(s) * (1.f / DM) + RMS_EPS);
    GAS unsigned long long* o8 = (GAS unsigned long long*)orow + lane;
#pragma unroll
    for (int j = 0; j < 4; ++j) { const f32x4 gg = gr[64 * j]; o8[64 * j] = (unsigned long long)pk2(v[j].x * r * gg.x, v[j].y * r * gg.y) | ((unsigned long long)pk2(v[j].z * r * gg.z, v[j].w * r * gg.w) << 32); }
}
__device__ __forceinline__ void sincos_acc(float af, float& s, float& c) {
    const double a = (double)af;
    const double k = rint(a * 0.63661977236758134308);
    const double y = fma(-k, 1.57079632679489661923, a) - k * 6.123233995736766e-17;
    const double y2 = y * y;
    double sp = -1.0 / 6227020800.0 * 0 + 1.0 / 6227020800.0;
    sp = fma(sp, y2, -1.0 / 39916800.0); sp = fma(sp, y2, 1.0 / 362880.0); sp = fma(sp, y2, -1.0 / 5040.0); sp = fma(sp, y2, 1.0 / 120.0); sp = fma(sp, y2, -1.0 / 6.0); sp = fma(sp, y2, 1.0);
    const double sy = y * sp;
    double cp = 1.0 / 87178291200.0 * -1.0;
    cp = fma(cp, y2, 1.0 / 479001600.0); cp = fma(cp, y2, -1.0 / 3628800.0); cp = fma(cp, y2, 1.0 / 40320.0); cp = fma(cp, y2, -1.0 / 720.0); cp = fma(cp, y2, 1.0 / 24.0); cp = fma(cp, y2, -0.5); cp = fma(cp, y2, 1.0);
    const int q = ((int)(long long)k) & 3;
    const double ss = (q == 0) ? sy : (q == 1) ? cp : (q == 2) ? -sy : -cp;
    const double cc = (q == 0) ? cp : (q == 1) ? -sy : (q == 2) ? -cp : sy;
    s = (float)ss; c = (float)cc;
}

namespace swa {
typedef short bf16x8 __attribute__((ext_vector_type(8)));
typedef short s16x4 __attribute__((ext_vector_type(4)));
typedef float f32x16 __attribute__((ext_vector_type(16)));
typedef float f32x4 __attribute__((ext_vector_type(4)));
typedef unsigned u32x4 __attribute__((ext_vector_type(4)));
typedef unsigned short bf16_t;
constexpr int D = 128, NW = 8, QBLK = 32, KVBLK = 64, QB = NW * QBLK, W = 129;
constexpr int SHM_V = KVBLK * D * 2, SHM_K = KVBLK * D * 2;
constexpr int OFF_WS = 2 * SHM_V + 2 * SHM_K, WS_PER_WAVE = 512, OFF_STG = OFF_WS + NW * WS_PER_WAVE, STG_LD = 132, STG_PER_WAVE = 16 * STG_LD * 4;
constexpr int LDS_BYTES = OFF_STG + NW * STG_PER_WAVE;
constexpr float SCALE = 0.08838834764831845f, THR = 8.f, C2 = 1.4426950408889634f * SCALE;
constexpr bool SK = true;
#define KSWZ(row, colB) ((row) * 256 + ((colB) ^ (((row) & 7) << 4)))
#define SBAR() __builtin_amdgcn_sched_barrier(0)
__device__ __forceinline__ int v_st(int k, int c) { const int kk = (k & ~0xC) | ((k & 4) << 1) | ((k & 8) >> 1); return ((kk >> 3) * 4 + (c >> 5)) * 512 + ((kk & 7) * 32 + (c & 31)) * 2; }
__device__ __forceinline__ int v_rd_base(int lane) { return ((lane & 3) << 3) | (((lane >> 2) & 3) << 6) | (((lane >> 4) & 1) << 5) | (((lane >> 5) & 1) << 8); }
constexpr int v_rd_off(int d0, int ks, int half) { return d0 * 512 + ks * 4096 + half * 2048; }
__device__ __forceinline__ int crow(int r, int hi) { return (r & 3) + 8 * (r >> 2) + 4 * hi; }
__device__ __forceinline__ unsigned cvtpk(float lo, float hi) { unsigned r; asm volatile("v_cvt_pk_bf16_f32 %0, %1, %2" : "=v"(r) : "v"(lo), "v"(hi)); return r; }
__device__ __forceinline__ bf16x8 load8(const bf16_t* p) { return *reinterpret_cast<const bf16x8*>(p); }
__device__ __forceinline__ void mask_tile(f32x16& p0, f32x16& p1, int dq, unsigned Wn) {
    const float NEG = -__builtin_inff();
#pragma unroll
    for (int r = 0; r < 16; ++r) {
        const int c = (r & 3) + 8 * (r >> 2);
        if ((unsigned)(dq - c) >= Wn) p0[r] = NEG;
        if ((unsigned)(dq - c - 32) >= Wn) p1[r] = NEG;
    }
}
__device__ __forceinline__ void partialSM(f32x16& p0, f32x16& p1, float& m_reg, float& mn, float& alpha) {
    float pmax = p0[0];
#pragma unroll
    for (int r = 1; r < 16; ++r) pmax = fmaxf(pmax, p0[r]);
#pragma unroll
    for (int r = 0; r < 16; ++r) pmax = fmaxf(pmax, p1[r]);
    { auto rr = __builtin_amdgcn_permlane32_swap(__float_as_uint(pmax), __float_as_uint(pmax), false, false);
      pmax = fmaxf(__uint_as_float(rr[0]), __uint_as_float(rr[1])); }
    if (__builtin_expect(__all((pmax - m_reg) * SCALE <= THR), 1)) { mn = m_reg; alpha = 1.f; }
    else { mn = fmaxf(m_reg, pmax); alpha = __builtin_amdgcn_exp2f((m_reg - mn) * C2); m_reg = mn; }
    const float mnL = -mn * C2;
#pragma unroll
    for (int r = 0; r < 16; ++r) p0[r] = fmaf(p0[r], C2, mnL);
#pragma unroll
    for (int r = 0; r < 16; ++r) p1[r] = fmaf(p1[r], C2, mnL);
#pragma unroll
    for (int r = 0; r < 16; ++r) p0[r] = __builtin_amdgcn_exp2f(p0[r]);
}
__device__ __forceinline__ void finishSM(f32x16& p0, f32x16& p1, float alpha, float& l_reg, bf16x8& pa0, bf16x8& pa1, bf16x8& pa2, bf16x8& pa3) {
#pragma unroll
    for (int r = 0; r < 16; ++r) p1[r] = __builtin_amdgcn_exp2f(p1[r]);
    float ps = 0;
#pragma unroll
    for (int r = 0; r < 16; ++r) ps += p0[r];
#pragma unroll
    for (int r = 0; r < 16; ++r) ps += p1[r];
    { auto rr = __builtin_amdgcn_permlane32_swap(__float_as_uint(ps), __float_as_uint(ps), false, false);
      ps = __uint_as_float(rr[0]) + __uint_as_float(rr[1]); }
    l_reg = l_reg * alpha + ps;
#define PK4(P, B_, OUT) do { unsigned a0 = cvtpk(P[B_+0], P[B_+1]), a1 = cvtpk(P[B_+2], P[B_+3]);                          \
        unsigned b0 = cvtpk(P[B_+4], P[B_+5]), b1 = cvtpk(P[B_+6], P[B_+7]);                                             \
        auto r0 = __builtin_amdgcn_permlane32_swap(a0, b0, false, false); auto r1 = __builtin_amdgcn_permlane32_swap(a1, b1, false, false); \
        u32x4 w = {r0[0], r1[0], r0[1], r1[1]}; OUT = *reinterpret_cast<bf16x8*>(&w); } while (0)
    PK4(p0, 0, pa0); PK4(p0, 8, pa1); PK4(p1, 0, pa2); PK4(p1, 8, pa3);
#undef PK4
}
template <int KB, bool SKIP>
__device__ __forceinline__ void qkt(f32x16& p0, f32x16& p1, const char* K_lds, int r32, int hi, const bf16x8* qr, bool act) {
    if (SKIP && !act) { const float NEG = -__builtin_inff();
#pragma unroll
        for (int r = 0; r < 16; ++r) { p0[r] = NEG; p1[r] = NEG; } return; }
    p0 = f32x16{}; p1 = f32x16{};
    const char* kb[4];
#pragma unroll
    for (int dd = 0; dd < 4; ++dd) kb[dd] = K_lds + KB * SHM_K + KSWZ(r32, (dd * 16 + hi * 8) * 2);
#pragma unroll
    for (int d0 = 0; d0 < 8; ++d0) { const char* a = kb[d0 & 3] + (d0 >> 2) * 128;
        bf16x8 b0 = *reinterpret_cast<const bf16x8*>(a);
        bf16x8 b1 = *reinterpret_cast<const bf16x8*>(a + 32 * 256);
        p0 = __builtin_amdgcn_mfma_f32_32x32x16_bf16(b0, qr[d0], p0, 0, 0, 0);
        p1 = __builtin_amdgcn_mfma_f32_32x32x16_bf16(b1, qr[d0], p1, 0, 0, 0); }
}
template <int VB, bool SKIP>
__device__ __forceinline__ void pv_tile(f32x16* o, int vb0, bf16x8 pa0, bf16x8 pa1, bf16x8 pa2, bf16x8 pa3, bool act) {
    if (SKIP && !act) return;
#define TRRD(dst, off) asm volatile("ds_read_b64_tr_b16 %0, %1 offset:%2" : "=&v"(dst) : "v"(vb0), "i"(off) : "memory")
#define PV_D0(d0) do { s16x4 l0, l1, l2, l3, h0, h1, h2, h3; constexpr int b_ = VB * SHM_V + v_rd_off(d0, 0, 0); \
        TRRD(l0, b_); TRRD(h0, b_ + 2048); TRRD(l1, b_ + 4096); TRRD(h1, b_ + 6144); TRRD(l2, b_ + 8192); TRRD(h2, b_ + 10240); TRRD(l3, b_ + 12288); TRRD(h3, b_ + 14336); \
        asm volatile("s_waitcnt lgkmcnt(0)" ::: "memory"); SBAR();   \
        o[d0] = __builtin_amdgcn_mfma_f32_32x32x16_bf16(pa0, (bf16x8){l0[0], l0[1], l0[2], l0[3], h0[0], h0[1], h0[2], h0[3]}, o[d0], 0, 0, 0);   \
        o[d0] = __builtin_amdgcn_mfma_f32_32x32x16_bf16(pa1, (bf16x8){l1[0], l1[1], l1[2], l1[3], h1[0], h1[1], h1[2], h1[3]}, o[d0], 0, 0, 0);   \
        o[d0] = __builtin_amdgcn_mfma_f32_32x32x16_bf16(pa2, (bf16x8){l2[0], l2[1], l2[2], l2[3], h2[0], h2[1], h2[2], h2[3]}, o[d0], 0, 0, 0);   \
        o[d0] = __builtin_amdgcn_mfma_f32_32x32x16_bf16(pa3, (bf16x8){l3[0], l3[1], l3[2], l3[3], h3[0], h3[1], h3[2], h3[3]}, o[d0], 0, 0, 0); } while (0)
    PV_D0(0); PV_D0(1); PV_D0(2); PV_D0(3);
#undef PV_D0
#undef TRRD
}
struct BlockRef { const bf16_t* Q; const bf16_t* K; const bf16_t* V; int P0; int R0; };
struct Seam { bf16x8 qr[8]; bf16x8 st_v0, st_v1, st_k0, st_k1; };
struct OutRefs { bf16_t* OA; float* LSE; const bf16_t* SZ; };
__device__ __forceinline__ int swa_jlo(int P0) { const int lowk = P0 - W + 1; return lowk > 0 ? lowk / KVBLK : 0; }
#define ROW(p, k0, rr) ((p) + (size_t)((k0) + (rr)) * D + sc)
#define VMW() asm volatile("s_waitcnt vmcnt(0)" ::: "memory")
#define VMWN(n) asm volatile("s_waitcnt vmcnt(%0)" :: "i"(n) : "memory")
#define SLOAD_H(Kp, Vp, k0) do { S.st_v0 = load8(ROW(Vp, k0, sr)); S.st_v1 = load8(ROW(Vp, k0, 32 + sr));              \
                         S.st_k0 = load8(ROW(Kp, k0, sr)); S.st_k1 = load8(ROW(Kp, k0, 32 + sr)); } while (0)
#define SWRITE_HK(bf) do { *(bf16x8*)(K_lds + (bf) * SHM_K + kws) = S.st_k0; *(bf16x8*)(K_lds + (bf) * SHM_K + kws + 32 * 256) = S.st_k1; } while (0)
#define SWRITE_HV(bf) do { *(bf16x8*)(V_lds + (bf) * SHM_V + vst0) = S.st_v0; *(bf16x8*)(V_lds + (bf) * SHM_V + vst1) = S.st_v1; } while (0)
#define SWRITE_H(bf) do { SWRITE_HV(bf); SWRITE_HK(bf); } while (0)
__device__ __forceinline__ void swa_prime(const BlockRef& cur, char* lds, Seam& S) {
    const int tid = threadIdx.x, wid = __builtin_amdgcn_readfirstlane(tid >> 6), lane = tid & 63, r32 = lane & 31, hi = lane >> 5;
    const int sr = tid >> 4, sc = (tid & 15) * 8, kws = KSWZ(sr, sc * 2); char* K_lds = lds + 2 * SHM_V;
    const int kb0 = swa_jlo(cur.P0) * KVBLK;
#pragma unroll
    for (int d0 = 0; d0 < 8; ++d0) S.qr[d0] = load8(cur.Q + (size_t)(wid * QBLK + r32) * D + d0 * 16 + hi * 8);
    SLOAD_H(cur.K, cur.V, kb0); VMW(); SWRITE_HK(0);
    __syncthreads();
}
template <int LOGD, bool FIRST, bool LAST>
__device__ __forceinline__ void swa_block(const BlockRef& cur, const BlockRef& nxt, int skv, char* lds, Seam& S, const OutRefs& out) {
    const int tid = threadIdx.x, wid = __builtin_amdgcn_readfirstlane(tid >> 6), lane = tid & 63, r32 = lane & 31, hi = lane >> 5;
    const int j_lo = swa_jlo(cur.P0);
    int j_hi = (cur.P0 + QB - 1) / KVBLK + 1; if (j_hi > skv / KVBLK) j_hi = skv / KVBLK;
    const int NT = j_hi - j_lo;
    const int kbn = swa_jlo(nxt.P0) * KVBLK;
    const int qlo = cur.P0 + wid * QBLK, qm = qlo + r32 - 4 * hi;
    char* V_lds = lds; char* K_lds = lds + 2 * SHM_V;
    float* ws = (float*)(lds + OFF_WS + wid * WS_PER_WAVE); float* li_l = ws, * al_l = ws + 32, * l2_l = ws + 64;
    float m_reg = -1e30f, l_reg = 0; f32x16 o[4] = {};
    const int sr = tid >> 4, sc = (tid & 15) * 8, vst0 = v_st(sr, sc), vst1 = v_st(32 + sr, sc), kws = KSWZ(sr, sc * 2);
    const int vb0 = (int)(uintptr_t)V_lds + v_rd_base(lane);
    const bf16_t* Kh = cur.K; const bf16_t* Vh = cur.V;
#define RESC(a) do { if (__any((a) < 1.f)) { if (hi == 0) al_l[r32] = (a); asm volatile("s_waitcnt lgkmcnt(0)" ::: "memory");              \
                     for (int d_ = 0; d_ < 4; ++d_) for (int r = 0; r < 16; ++r) o[d_][r] *= al_l[crow(r, hi)]; } } while (0)
#define KBASE(t) ((j_lo + (t)) * KVBLK)
#define ACT(t) (KBASE(t) <= qlo + QBLK - 1 && KBASE(t) + KVBLK - 1 >= qlo - W + 1)
#define MASKT(P0_, P1_, t) do { const int kb_ = KBASE(t); if ((!SK || ACT(t)) && (kb_ + KVBLK - 1 > qlo || kb_ <= qlo + QBLK - 1 - W)) mask_tile(P0_, P1_, qm - kb_, (unsigned)W); } while (0)
#define SEAM_K0() do { VMWN(8); SWRITE_HK(0); SBAR(); } while (0)
    f32x16 pA0, pA1, pB0, pB1; float mnA, mnB, alA, alB; bf16x8 pa0, pa1, pa2, pa3;
    SWRITE_HV(0); SBAR();
    if (NT > 1) { SLOAD_H(Kh, Vh, KBASE(1)); }
    SBAR(); qkt<0, SK>(pA0, pA1, K_lds, r32, hi, S.qr, ACT(0));
    MASKT(pA0, pA1, 0); partialSM(pA0, pA1, m_reg, mnA, alA);
    if (NT > 1) { VMW(); SWRITE_H(1); }
    __syncthreads();
#define HALF_STEP(PX0, PX1, mnX, alX, PY0, PY1, alY, t, KB, VB, SB) do {                                                      \
        SBAR(); qkt<KB, SK>(PX0, PX1, K_lds, r32, hi, S.qr, ACT(t));                                             \
        finishSM(PY0, PY1, alY, l_reg, pa0, pa1, pa2, pa3); SBAR();                                                           \
        if ((t) + 1 < NT) { SLOAD_H(Kh, Vh, KBASE((t) + 1)); SBAR(); }                                               \
        pv_tile<VB, SK>(o, vb0, pa0, pa1, pa2, pa3, ACT((t) - 1)); MASKT(PX0, PX1, (t)); partialSM(PX0, PX1, m_reg, mnX, alX);                                        \
        __syncthreads();                                                                                                      \
        if ((t) + 1 < NT) { VMW(); SWRITE_H(SB); }                                                                          \
        RESC(alX); __syncthreads(); } while (0)
    for (int t = 1; t + 1 < NT; t += 2) {
        HALF_STEP(pB0, pB1, mnB, alB, pA0, pA1, alA, t, 1, 0, 0);
        HALF_STEP(pA0, pA1, mnA, alA, pB0, pB1, alB, t + 1, 0, 1, 1);
    }
    const bool even = (NT & 1) == 0;
    if (even) { SBAR(); qkt<1, SK>(pB0, pB1, K_lds, r32, hi, S.qr, ACT(NT - 1)); SBAR(); }
    SLOAD_H(nxt.K, nxt.V, kbn); SBAR();
#pragma unroll
    for (int d0 = 0; d0 < 8; ++d0) S.qr[d0] = load8(nxt.Q + (size_t)(wid * QBLK + r32) * D + d0 * 16 + hi * 8);
    SBAR();
    finishSM(pA0, pA1, alA, l_reg, pa0, pa1, pa2, pa3); SBAR();
    pv_tile<0, SK>(o, vb0, pa0, pa1, pa2, pa3, ACT(even ? NT - 2 : NT - 1));
    if (even) { MASKT(pB0, pB1, NT - 1); partialSM(pB0, pB1, m_reg, mnB, alB); __syncthreads(); RESC(alB);
        finishSM(pB0, pB1, alB, l_reg, pa0, pa1, pa2, pa3); SBAR(); pv_tile<1, SK>(o, vb0, pa0, pa1, pa2, pa3, ACT(NT - 1)); }
    SBAR(); SEAM_K0();
    if (hi == 0) { li_l[r32] = l_reg; l2_l[r32] = m_reg * C2 + __builtin_amdgcn_logf(l_reg); }
    asm volatile("s_waitcnt lgkmcnt(0)" ::: "memory");
    float rli[16];
#pragma unroll
    for (int r = 0; r < 16; ++r) rli[r] = __builtin_amdgcn_rcpf(li_l[crow(r, hi)]);
    float* stg = (float*)(lds + OFF_STG + wid * STG_PER_WAVE);
    constexpr int LOGL = 13 - LOGD, LM1 = (1 << LOGL) - 1;
#pragma unroll
    for (int ps = 0; ps < 2; ++ps) {
#pragma unroll
        for (int rr = 0; rr < 8; ++rr) { const int r = 8 * ps + rr, lrow = (rr & 3) + 8 * (rr >> 2) + 4 * hi;
#pragma unroll
            for (int d0 = 0; d0 < 4; ++d0) stg[lrow * STG_LD + d0 * 32 + r32] = o[d0][r] * rli[r]; }
        asm volatile("s_waitcnt lgkmcnt(0)" ::: "memory");
        int le = lane; asm volatile("" : "+v"(le));
        const int lrow = le >> 2, q4 = le & 3, q = 16 * ps + lrow, R = cur.R0 + wid * QBLK + q;
        const int bh = R >> 13, rem = R & 8191, rs = rem >> LOGL, mm = rem & LM1, tt = (mm << LOGD) + rs;
        const size_t tok = (size_t)(bh >> 4) * 8192 + tt; const int h = bh & 15;
        float wa = 0.f, wb = 1.f, Ln = l2_l[q];
        if (!FIRST) { const float La = out.LSE[tok * 16 + h], Lb = Ln; const float Lm = fmaxf(La, Lb); const float ea = __builtin_amdgcn_exp2f(La - Lm), eb = __builtin_amdgcn_exp2f(Lb - Lm), sw = ea + eb, is = __builtin_amdgcn_rcpf(sw);
            wa = ea * is; wb = eb * is; Ln = Lm + __builtin_amdgcn_logf(sw); }
#pragma unroll
        for (int c = 0; c < 4; ++c) { const int dims = c * 32 + q4 * 8; const size_t off = tok * 2048 + (size_t)h * 128 + dims;
            f32x4 x0 = *(const f32x4*)(stg + lrow * STG_LD + dims), x1 = *(const f32x4*)(stg + lrow * STG_LD + dims + 4);
            if (!FIRST) { const u32x4 ua = *(const u32x4*)(out.OA + off);
                const f32x4 a0 = {__uint_as_float(ua.x << 16), __uint_as_float(ua.x & 0xffff0000u), __uint_as_float(ua.y << 16), __uint_as_float(ua.y & 0xffff0000u)};
                const f32x4 a1 = {__uint_as_float(ua.z << 16), __uint_as_float(ua.z & 0xffff0000u), __uint_as_float(ua.w << 16), __uint_as_float(ua.w & 0xffff0000u)};
                x0 = a0 * wa + x0 * wb; x1 = a1 * wa + x1 * wb; }
            if (LAST) { const u32x4 uz = *(const u32x4*)(out.SZ + off);
                const f32x4 z0 = {__uint_as_float(uz.x << 16), __uint_as_float(uz.x & 0xffff0000u), __uint_as_float(uz.y << 16), __uint_as_float(uz.y & 0xffff0000u)};
                const f32x4 z1 = {__uint_as_float(uz.z << 16), __uint_as_float(uz.z & 0xffff0000u), __uint_as_float(uz.w << 16), __uint_as_float(uz.w & 0xffff0000u)};
                x0 = x0 * z0; x1 = x1 * z1; }
            u32x4 w = {cvtpk(x0[0], x0[1]), cvtpk(x0[2], x0[3]), cvtpk(x1[0], x1[1]), cvtpk(x1[2], x1[3])};
            *(u32x4*)(out.OA + off) = w; }
        if (!LAST && q4 == 0) out.LSE[tok * 16 + h] = Ln;
        asm volatile("s_waitcnt lgkmcnt(0)" ::: "memory");
    }
    __syncthreads();
#undef RESC
#undef KBASE
#undef ACT
#undef MASKT
#undef SEAM_K0
#undef HALF_STEP
}
#undef ROW
#undef VMW
#undef VMWN
#undef SLOAD_H
#undef SWRITE_HK
#undef SWRITE_HV
#undef SWRITE_H
#undef KSWZ
#undef SBAR
}

__device__ __forceinline__ void p0_prologue(Frame& F, const Args& a) {
    LAS float* scr = (LAS float*)(F.lds + RING_OFF + F.wave * 16384);
    const int tid = tid_now(), lane = tid & 63;
    const int gw = F.vcu * NWAVES + F.wave, NGW = F.G * NWAVES;
    bf16* WA = (bf16*)(a.ws + WS_WINT_A); bf16* WB = (bf16*)(a.ws + WS_WINT_B); bf16* XN0 = (bf16*)(a.ws + WS_XN0);
    constexpr int NB = NIN / 32, NITEMS = (DM / 64) * NB;
    for (int it = gw; it < NITEMS; it += NGW) {
        const int kb = it / NB, nb = it % NB, k0 = 64 * kb, n0 = 32 * nb;
        bf16* dst = (n0 < 2 * NGRP) ? WA + (size_t)n0 * DM + k0 : WB + (size_t)(n0 - 2 * NGRP) * DM + k0;
        transpose_tile(a.attn_w_in + (size_t)k0 * NIN + n0, NIN, dst, DM, scr, lane);
    }
    for (int m = gw; m < M; m += NGW) rms_row_to_bf16(a.x + (size_t)m * DM, a.norm_pre, XN0 + (size_t)m * DM, lane);
    float* rope = (float*)(a.ws + WS_ROPE);
    constexpr float IF[16] = {1.f, 0.440366596f, 0.193922743f, 0.0853971019f, 0.0376060307f, 0.016560439f, 0.00729266461f, 0.00321144587f,
                              0.00141421356f, 0.000622772379f, 0.000274248188f, 0.000120769735f, 5.3182961e-05f, 2.34199997e-05f, 1.03133862e-05f, 4.54167048e-06f};
    for (int m = F.vcu * 512 + tid; m < M; m += F.G * 512) {
        const float p = (float)a.pos[m];
#pragma unroll
        for (int i = 0; i < 16; ++i) { float s, c; sincos_acc(p * IF[i], s, c); rope[(size_t)m * 32 + i] = c; rope[(size_t)m * 32 + 16 + i] = s; }
    }
}

__device__ __forceinline__ void w1_prep(Frame& F, const Args& a) {
    LAS float* scr = (LAS float*)(F.lds + RING_OFF + F.wave * 16384);
    const int gw = F.vcu * NWAVES + F.wave, NGW = F.G * NWAVES, lane = tid_now() & 63;
    bf16* WP1T = (bf16*)(a.ws + WS_WP1T); bf16* WOUTT = (bf16*)(a.ws + WS_WOUTT); bf16* WPOUTT = (bf16*)(a.ws + WS_WPOUTT);
    for (int it = gw; it < 3072; it += NGW) {
        if (it < 2048) { const int r = it & 1023, kb = r >> 5, nb = r & 31; const float* W = (it < 1024) ? a.attn_w_out : a.pool_w_out; bf16* T = (it < 1024) ? WOUTT : WPOUTT;
            transpose_tile(W + (size_t)(kb * 64) * DM + nb * 32, DM, T + (size_t)(nb * 32) * EW + kb * 64, EW, scr, lane); }
        else { const int r = it - 2048, kb = r >> 6, nb = r & 63;
            transpose_tile(a.pool_w_in + (size_t)(kb * 64) * 4096 + 2048 + nb * 32, 4096, WP1T + (size_t)(2048 + nb * 32) * DM + kb * 64, DM, scr, lane); }
    }
    typedef float f32x16 __attribute__((ext_vector_type(16)));
    for (int tile = gw; tile < 2048; tile += NGW) {
        const int g = tile >> 9, d0 = ((tile >> 5) & 15) * 32, k0 = (tile & 31) * 32;
        f32x16 acc = {};
        const float* ap = a.pool_w_grp + (size_t)g * 512 * 512 + (size_t)(lane >> 5) * 512 + d0 + (lane & 31);
        const float* bp = a.pool_w_in + (size_t)(k0 + (lane & 31)) * 4096 + g * 512 + (lane >> 5);
#pragma unroll 8
        for (int c0 = 0; c0 < 512; c0 += 2) { const float av = ap[(size_t)c0 * 512], bv = bp[c0]; acc = __builtin_amdgcn_mfma_f32_32x32x2f32(av, bv, acc, 0, 0, 0); }
#pragma unroll
        for (int r = 0; r < 16; ++r) { const int i = (r & 3) + 8 * (r >> 2) + 4 * (lane >> 5);
            WP1T[(size_t)(g * 512 + d0 + i) * DM + k0 + (lane & 31)] = (bf16)f2bf(acc[r]); }
    }
}

template <int LOGD, bool FIRST, bool LAST>
__device__ __forceinline__ void attn_naive(Frame& F, const Args& a) {
    constexpr int LOGL = 13 - LOGD, L = 1 << LOGL;
    const bf16* Qb = (const bf16*)(a.ws + WS_QKV); const bf16* Kb = Qb + (size_t)32 * 8192 * 128; const bf16* Vb = Kb + (size_t)32 * 8192 * 128;
    bf16* OA = (bf16*)a.out; float* LSE = (float*)(a.ws + WS_LSE); const bf16* SZ = (const bf16*)(a.ws + WS_SZ);
    LAS float* qs = (LAS float*)(F.lds + RING_OFF + F.wave * 2048); LAS float* ps = qs + 128;
    const int gw = F.vcu * NWAVES + F.wave, NGW = F.G * NWAVES, lane = tid_now() & 63;
    for (int R = gw; R < 32 * 8192; R += NGW) {
        const int bh = R >> 13, rem = R & 8191, r = rem >> LOGL, m = rem & (L - 1), t = (m << LOGD) + r, b = bh >> 4, h = bh & 15;
        { const unsigned u = *(const GAS unsigned*)(Qb + (size_t)R * 128 + 2 * lane); qs[2 * lane] = bf2f(u & 0xffffu); qs[2 * lane + 1] = bf2f(u >> 16); }
        LDS_WAIT(); asm volatile("" ::: "memory");
        const int nk = (m < 128 ? m : 128) + 1;
        float sc[3];
#pragma unroll
        for (int rd = 0; rd < 3; ++rd) {
            const int j = rd * 64 + lane; float s = -INFINITY;
            if (j < nk) { const GAS v4u* kr = (const GAS v4u*)(Kb + (size_t)(R - j) * 128); float acc = 0.f;
#pragma unroll 4
                for (int c = 0; c < 16; ++c) { const v4u w = kr[c];
                    acc += qs[8 * c + 0] * bf2f(w.x & 0xffffu) + qs[8 * c + 1] * bf2f(w.x >> 16) + qs[8 * c + 2] * bf2f(w.y & 0xffffu) + qs[8 * c + 3] * bf2f(w.y >> 16)
                         + qs[8 * c + 4] * bf2f(w.z & 0xffffu) + qs[8 * c + 5] * bf2f(w.z >> 16) + qs[8 * c + 6] * bf2f(w.w & 0xffffu) + qs[8 * c + 7] * bf2f(w.w >> 16); }
                s = acc * SM_SCALE; }
            sc[rd] = s; }
        const float mx = wave_max(fmaxf(fmaxf(sc[0], sc[1]), sc[2]));
        float den = 0.f;
#pragma unroll
        for (int rd = 0; rd < 3; ++rd) { const int j = rd * 64 + lane; const float p = (j < nk) ? exp2f((sc[rd] - mx) * LOG2E) : 0.f; den += p; ps[j] = p; }
        den = wave_sum(den);
        LDS_WAIT(); asm volatile("" ::: "memory");
        float o0 = 0.f, o1 = 0.f;
        for (int j = 0; j < nk; ++j) { const float pj = ps[j]; const unsigned u = *(const GAS unsigned*)(Vb + (size_t)(R - j) * 128 + 2 * lane); o0 += pj * bf2f(u & 0xffffu); o1 += pj * bf2f(u >> 16); }
        const float inv = 1.f / den; o0 *= inv; o1 *= inv;
        float L2 = mx * LOG2E + log2f(den);
        const size_t tok = (size_t)b * 8192 + t, oi = tok * 2048 + h * 128 + 2 * lane, li = tok * 16 + h;
        if (!FIRST) { const float La = LSE[li]; const unsigned u = *(const GAS unsigned*)(OA + oi); const float a0 = bf2f(u & 0xffffu), a1 = bf2f(u >> 16);
            const float Ln = fmaxf(La, L2), wa = exp2f(La - Ln), wb = exp2f(L2 - Ln), sw = wa + wb, is = 1.f / sw;
            o0 = (a0 * wa + o0 * wb) * is; o1 = (a1 * wa + o1 * wb) * is; L2 = Ln + log2f(sw); }
        if (LAST) { const unsigned z = *(const GAS unsigned*)(SZ + oi); o0 *= bf2f(z & 0xffffu); o1 *= bf2f(z >> 16); }
        *(GAS unsigned*)(OA + oi) = pk2(o0, o1);
        if (!LAST && lane == 0) LSE[li] = L2;
        LDS_WAIT(); asm volatile("" ::: "memory");
    }
}

__device__ __forceinline__ void p3_norm(Frame& F, const Args& a) {
    const int gw = F.vcu * NWAVES + F.wave, NGW = F.G * NWAVES, lane = tid_now() & 63;
    const float* T = (const float*)(a.ws + WS_V1); float* H1 = (float*)(a.ws + WS_H1); bf16* XN1 = (bf16*)(a.ws + WS_XN1);
    const GAS f32x4* gp = (const GAS f32x4*)(a.norm_post) + lane; const GAS f32x4* gq = (const GAS f32x4*)(a.norm_pre + DM) + lane;
    for (int m = gw; m < M; m += NGW) {
        const GAS f32x4* tr = (const GAS f32x4*)(T + (size_t)m * DM) + lane; const GAS f32x4* xr = (const GAS f32x4*)(a.x + (size_t)m * DM) + lane;
        f32x4 v[4]; float s = 0.f;
#pragma unroll
        for (int j = 0; j < 4; ++j) { v[j] = tr[64 * j]; s += (v[j].x * v[j].x + v[j].y * v[j].y) + (v[j].z * v[j].z + v[j].w * v[j].w); }
        const float r1 = 1.f / sqrtf(wave_sum(s) * (1.f / DM) + RMS_EPS); float s2 = 0.f;
        GAS f32x4* hr = (GAS f32x4*)(H1 + (size_t)m * DM) + lane;
#pragma unroll
        for (int j = 0; j < 4; ++j) { v[j] = xr[64 * j] + v[j] * r1 * gp[64 * j]; hr[64 * j] = v[j]; s2 += (v[j].x * v[j].x + v[j].y * v[j].y) + (v[j].z * v[j].z + v[j].w * v[j].w); }
        const float r2 = 1.f / sqrtf(wave_sum(s2) * (1.f / DM) + RMS_EPS);
        GAS unsigned long long* o8 = (GAS unsigned long long*)(XN1 + (size_t)m * DM) + lane;
#pragma unroll
        for (int j = 0; j < 4; ++j) { const f32x4 gg = gq[64 * j]; o8[64 * j] = (unsigned long long)pk2(v[j].x * r2 * gg.x, v[j].y * r2 * gg.y) | ((unsigned long long)pk2(v[j].z * r2 * gg.z, v[j].w * r2 * gg.w) << 32); }
    }
}
__device__ __forceinline__ void p5_pool(Frame& F, const Args& a) {
    const bf16* V1 = (const bf16*)(a.ws + WS_V1); const bf16* SZ1 = (const bf16*)(a.ws + WS_SZ1); bf16* Y2 = (bf16*)(a.ws + WS_Y2);
    for (int idx = F.vcu * 512 + tid_now(); idx < M * 256; idx += F.G * 512) {
        const int row = idx >> 8, col0 = (idx & 255) * 8, g = col0 >> 9, w = 2 << g, t = row & 8191, cnt = (t + 1 < w) ? t + 1 : w;
        float sum[8], own[8];
#pragma unroll
        for (int e = 0; e < 8; ++e) sum[e] = 0.f;
        for (int j = 0; j < cnt; ++j) { const v4u q = *(const GAS v4u*)(V1 + (size_t)(row - j) * EW + col0);
            const float f[8] = {bf2f(q.x & 0xffffu), bf2f(q.x >> 16), bf2f(q.y & 0xffffu), bf2f(q.y >> 16), bf2f(q.z & 0xffffu), bf2f(q.z >> 16), bf2f(q.w & 0xffffu), bf2f(q.w >> 16)};
#pragma unroll
            for (int e = 0; e < 8; ++e) { sum[e] += f[e]; if (j == 0) own[e] = f[e]; } }
        const float ic = 1.f / (float)cnt;
        const v4u zq = *(const GAS v4u*)(SZ1 + (size_t)row * EW + col0);
        const float zf[8] = {bf2f(zq.x & 0xffffu), bf2f(zq.x >> 16), bf2f(zq.y & 0xffffu), bf2f(zq.y >> 16), bf2f(zq.z & 0xffffu), bf2f(zq.z >> 16), bf2f(zq.w & 0xffffu), bf2f(zq.w >> 16)};
        float y[8];
#pragma unroll
        for (int e = 0; e < 8; ++e) y[e] = ((sum[e] * ic - own[e]) + a.pool_b_grp[col0 + e]) * a.pool_scale[col0 + e] * zf[e];
        v4u o; o.x = pk2(y[0], y[1]); o.y = pk2(y[2], y[3]); o.z = pk2(y[4], y[5]); o.w = pk2(y[6], y[7]);
        *(GAS v4u*)(Y2 + (size_t)row * EW + col0) = o;
    }
}
__device__ __forceinline__ void p6_norm(Frame& F, const Args& a) {
    const int gw = F.vcu * NWAVES + F.wave, NGW = F.G * NWAVES, lane = tid_now() & 63;
    const float* T = (const float*)(a.ws + WS_SZ1); const float* H1 = (const float*)(a.ws + WS_H1);
    const GAS f32x4* gp = (const GAS f32x4*)(a.norm_post + DM) + lane;
    for (int m = gw; m < M; m += NGW) {
        const GAS f32x4* tr = (const GAS f32x4*)(T + (size_t)m * DM) + lane; const GAS f32x4* hr = (const GAS f32x4*)(H1 + (size_t)m * DM) + lane;
        f32x4 v[4]; float s = 0.f;
#pragma unroll
        for (int j = 0; j < 4; ++j) { v[j] = tr[64 * j]; s += (v[j].x * v[j].x + v[j].y * v[j].y) + (v[j].z * v[j].z + v[j].w * v[j].w); }
        const float r1 = 1.f / sqrtf(wave_sum(s) * (1.f / DM) + RMS_EPS);
        GAS f32x4* orow = (GAS f32x4*)(a.out + (size_t)m * DM) + lane;
#pragma unroll
        for (int j = 0; j < 4; ++j) orow[64 * j] = hr[64 * j] + v[j] * r1 * gp[64 * j];
    }
}

__device__ __forceinline__ swa::BlockRef swa_ref(const bf16* Qb, const bf16* Kb, const bf16* Vb, int I, int LOGL) {
    swa::BlockRef r; const int R0 = I * 256, S0 = (R0 >> LOGL) << LOGL;
    r.Q = Qb + (size_t)R0 * 128; r.K = Kb + (size_t)S0 * 128; r.V = Vb + (size_t)S0 * 128; r.P0 = R0 - S0; r.R0 = R0; return r;
}
template <int LOGD, bool FIRST, bool LAST>
__device__ __forceinline__ void attn_phase(int vcu, int G, unsigned char* ws, float* outp, char* lds) {
    constexpr int LOGL = 13 - LOGD, L = 1 << LOGL, NBLK = 32 * 8192 / 256;
    const bf16* Qb = (const bf16*)(ws + WS_QKV); const bf16* Kb = Qb + (size_t)32 * 8192 * 128; const bf16* Vb = Kb + (size_t)32 * 8192 * 128;
    const swa::OutRefs out{(bf16*)outp, (float*)(ws + WS_LSE), (const bf16*)(ws + WS_SZ)};
    const bool even = (NBLK % G) == 0; const int per = NBLK / G;
    int I = even ? vcu * per : vcu; const int step = even ? 1 : G; const int Iend = even ? (vcu + 1) * per : NBLK;
    if (I >= Iend) return;
    swa::BlockRef cur = swa_ref(Qb, Kb, Vb, I, LOGL); swa::Seam S;
    swa::swa_prime(cur, lds, S);
    for (;;) {
        const int In = I + step; const bool last = In >= Iend;
        const swa::BlockRef nxt = last ? cur : swa_ref(Qb, Kb, Vb, In, LOGL);
        swa::swa_block<LOGD, FIRST, LAST>(cur, nxt, L, lds, S, out);
        if (last) break;
        cur = nxt; I = In;
    }
}

#ifndef MK_PER_PHASE
#define MK_PER_PHASE 0
#endif
constexpr int N_PHASES = 13;
__global__ void __launch_bounds__(NWAVES * 64, 2) skel_fwd(Args args) {
    extern __shared__ __attribute__((aligned(16))) unsigned char lds[];
    Frame F;
    F.lds = (LAS unsigned char*)lds;
    F.MISC = (volatile LAS unsigned*)(F.lds + MISC_OFF);
    F.wave = __builtin_amdgcn_readfirstlane(threadIdx.x >> 6);
    F.G = gridDim.x; { const int bx = blockIdx.x; F.vcu = (F.G % 8 == 0) ? (bx % 8) * (F.G / 8) + bx / 8 : bx; }
    unsigned char* ws = args.ws;
    F.ctl = (gu32*)(ws + WS_CTL);
    for (int u = threadIdx.x; u < (LDS_BYTES - LDSCTL_OFF) / 4; u += NWAVES * 64) ((LAS unsigned*)(F.lds + LDSCTL_OFF))[u] = 0u;
    __syncthreads();
    XcdBarrier bar; bar.bar = (unsigned*)(F.ctl + CW_BAR); bar.x = 0; bar.st = nullptr;
    if (!MK_PER_PHASE) bar = xcd_barrier_post((unsigned*)(F.ctl + CW_BAR), F.MISC + 8);
    const int lo = args.ph_lo, hi = args.ph_hi;
#define IN(k) (lo <= (k) && (k) < hi)
#define SEAM(k) do { if (IN(k) && IN((k) + 1)) xcd_barrier(bar); } while (0)
    bf16* XN0 = (bf16*)(ws + WS_XN0); bf16* Qb = (bf16*)(ws + WS_QKV); bf16* Kb = Qb + (size_t)32 * 8192 * 128; bf16* Vb = Kb + (size_t)32 * 8192 * 128;
    bf16* SZ = (bf16*)(ws + WS_SZ); const float* rope = (const float*)(ws + WS_ROPE);

    if (IN(0)) { p0_prologue(F, args); SEAM(0); }
    if (IN(1)) { pg8::Gemm g{XN0, (const bf16*)(ws + WS_WINT_A), M, NGRP, DM}; pg8::StaticOrder S; S.init(M, NGRP, F.G, (int)blockIdx.x);
        pg8::EpiQKV<0> E{Qb, SZ, rope};
        pg8::gemm_phase<pg8::EpiQKV<0>, pg8::StaticOrder, true, true>(F.lds + RING_OFF, g, S, E); SEAM(1); }
    if (IN(2)) { attn_phase<0, true, false>(F.vcu, F.G, ws, args.out, (char*)lds); SEAM(2); }
    if (IN(3)) { pg8::Gemm g{XN0, (const bf16*)(ws + WS_WINT_A) + (size_t)NGRP * DM, M, NGRP, DM}; pg8::StaticOrder S; S.init(M, NGRP, F.G, (int)blockIdx.x);
        pg8::EpiQKV<2> E{Qb, SZ, rope};
        pg8::gemm_phase<pg8::EpiQKV<2>, pg8::StaticOrder, true, true>(F.lds + RING_OFF, g, S, E); SEAM(3); }
    if (IN(4)) { attn_phase<2, false, false>(F.vcu, F.G, ws, args.out, (char*)lds); SEAM(4); }
    if (IN(5)) { pg8::Gemm g{XN0, (const bf16*)(ws + WS_WINT_B), M, NGRP + EW, DM}; pg8::StaticOrder S; S.init(M, NGRP + EW, F.G, (int)blockIdx.x);
        pg8::EpiQKV<4> E{Qb, SZ, rope};
        pg8::gemm_phase<pg8::EpiQKV<4>, pg8::StaticOrder, true, true>(F.lds + RING_OFF, g, S, E); SEAM(5); }
    if (IN(6)) { w1_prep(F, args); __syncthreads(); attn_phase<4, false, true>(F.vcu, F.G, ws, args.out, (char*)lds); SEAM(6); }
    if (IN(7)) { pg8::Gemm g{(const bf16*)args.out, (const bf16*)(ws + WS_WOUTT), M, DM, EW}; pg8::StaticOrder S; S.init(M, DM, F.G, (int)blockIdx.x);
        pg8::EpiF32 E{(float*)(ws + WS_V1), DM};
        pg8::gemm_phase<pg8::EpiF32, pg8::StaticOrder, true, true>(F.lds + RING_OFF, g, S, E); SEAM(7); }
    if (IN(8)) { p3_norm(F, args); SEAM(8); }
    if (IN(9)) { pg8::Gemm g{(const bf16*)(ws + WS_XN1), (const bf16*)(ws + WS_WP1T), M, 2 * EW, DM}; pg8::StaticOrder S; S.init(M, 2 * EW, F.G, (int)blockIdx.x);
        pg8::EpiVZ E{(bf16*)(ws + WS_V1), (bf16*)(ws + WS_SZ1)};
        pg8::gemm_phase<pg8::EpiVZ, pg8::StaticOrder, true, true>(F.lds + RING_OFF, g, S, E); SEAM(9); }
    if (IN(10)) { p5_pool(F, args); SEAM(10); }
    if (IN(11)) { pg8::Gemm g{(const bf16*)(ws + WS_Y2), (const bf16*)(ws + WS_WPOUTT), M, DM, EW}; pg8::StaticOrder S; S.init(M, DM, F.G, (int)blockIdx.x);
        pg8::EpiF32 E{(float*)(ws + WS_SZ1), DM};
        pg8::gemm_phase<pg8::EpiF32, pg8::StaticOrder, true, true>(F.lds + RING_OFF, g, S, E); SEAM(11); }
    if (IN(12)) { p6_norm(F, args); }
#undef IN
#undef SEAM
}

extern "C" void kernel_launch(void* const* d_in, const int* in_sizes, int n_in, void* d_out, int out_size, void* d_ws, size_t ws_size, hipStream_t stream) {
    static int grid = 0;
    if (grid == 0) {
        if (n_in != 11 || in_sizes[0] != M * DM || out_size != M * DM || ws_size < WS_END) {
            fprintf(stderr, "kernel_launch: shape/workspace mismatch: n_in %d in0 %d out %d ws %zu (need %zu); nothing launched\n", n_in, n_in > 0 ? in_sizes[0] : -1, out_size, ws_size, (size_t)WS_END); grid = -1; return; }
        int dev = 0, cus = 0, per_cu = 0;
        if (hipGetDevice(&dev) != hipSuccess || hipDeviceGetAttribute(&cus, hipDeviceAttributeMultiprocessorCount, dev) != hipSuccess) { grid = -1; return; }
        if (hipFuncSetAttribute((const void*)skel_fwd, hipFuncAttributeMaxDynamicSharedMemorySize, LDS_BYTES) != hipSuccess) { fprintf(stderr, "kernel_launch: hipFuncSetAttribute failed\n"); grid = -1; return; }
        if (hipOccupancyMaxActiveBlocksPerMultiprocessor(&per_cu, (const void*)skel_fwd, NWAVES * 64, LDS_BYTES) != hipSuccess || per_cu < 1) {
            fprintf(stderr, "kernel_launch: occupancy query reports %d workgroups per CU\n", per_cu); }
        (void)hipGetLastError();
        grid = cus;
    }
    if (grid < 0) return;
    if (hipMemsetAsync((char*)d_ws + WS_CTL, 0, CTL_ZERO_BYTES, stream) != hipSuccess) { fprintf(stderr, "kernel_launch: hipMemsetAsync failed\n"); return; }
    Args a{};
    a.x = (const float*)d_in[0]; a.pos = (const int*)d_in[1]; a.norm_pre = (const float*)d_in[2]; a.norm_post = (const float*)d_in[3];
    a.attn_w_in = (const float*)d_in[4]; a.attn_w_out = (const float*)d_in[5]; a.pool_w_in = (const float*)d_in[6]; a.pool_w_grp = (const float*)d_in[7];
    a.pool_b_grp = (const float*)d_in[8]; a.pool_scale = (const float*)d_in[9]; a.pool_w_out = (const float*)d_in[10];
    a.out = (float*)d_out; a.ws = (unsigned char*)d_ws;
#if MK_PER_PHASE
    for (int p = 0; p < N_PHASES; ++p) { a.ph_lo = p; a.ph_hi = p + 1; a.li = p;
        hipLaunchKernelGGL(skel_fwd, dim3(grid), dim3(NWAVES * 64), LDS_BYTES, stream, a);
        const hipError_t le = hipPeekAtLastError(); if (le != hipSuccess) { fprintf(stderr, "kernel_launch: launch %d failed: %s\n", p, hipGetErrorName(le)); break; } }
#else
    a.ph_lo = 0; a.ph_hi = N_PHASES; a.li = 0;
    hipLaunchKernelGGL(skel_fwd, dim3(grid), dim3(NWAVES * 64), LDS_BYTES, stream, a);
    const hipError_t le = hipPeekAtLastError(); if (le != hipSuccess) fprintf(stderr, "kernel_launch: launch failed: %s\n", hipGetErrorName(le));
#endif
}
```
